# Optimizing an MI355X kernel written in HIP

```python
import math
import jax, jax.numpy as jnp
from jax import lax
import numpy as np

D_MODEL = 1024
BATCH = 2
SEQ = 16384
DEPTH = 2

N_A_LAYERS = DEPTH // 2
N_B_LAYERS = DEPTH - N_A_LAYERS
D_FF = 2816
A_HEADS = 8
A_KEY_DIM = 128
A_VAL_DIM = D_MODEL // A_HEADS
A_FORGET_DIM = A_HEADS * A_KEY_DIM
A_VAL_WIDTH = A_HEADS * A_VAL_DIM
A_IN_WIDTH = 2 * A_FORGET_DIM + 2 * A_VAL_WIDTH
A_CHUNK = 64
B_WINDOWS = (128, 512, 2048)
B_DILATIONS = (1, 4, 16)
B_GROUPS = 3
B_HEADS = 16
B_HEAD_DIM = D_MODEL // B_HEADS
B_QKV_WIDTH = B_GROUPS * B_HEADS * B_HEAD_DIM
B_BLOCK = 128
NUM_BUCKETS = 32
MAX_DISTANCE = 2048
EPS = 1e-6

kernel_name = 'yoco_hgrn2_dilated_macaron'


def _rms(x, gain):
    xf = x.astype(jnp.float32)
    y = xf * lax.rsqrt(jnp.mean(xf * xf, axis=-1, keepdims=True) + EPS)
    return (y * gain.astype(jnp.float32)).astype(x.dtype)


def _swiglu(h, w_in, w_out):
    gate, up = jnp.split(h @ w_in, 2, axis=-1)
    return (jax.nn.silu(gate) * up) @ w_out


def _lower_bounds(lb_logits):
    p = jax.nn.softmax(lb_logits.astype(jnp.float32), axis=0)
    return jnp.cumsum(p, axis=0)[:-1]


def _hgrn2(h, w_in, lb, out_gain, w_out):
    bsz, seq, _ = h.shape
    n_chunks = seq // A_CHUNK
    f32 = jnp.float32
    q, f, i, g = jnp.split(h @ w_in, [A_FORGET_DIM, 2 * A_FORGET_DIM, 2 * A_FORGET_DIM + A_VAL_WIDTH], axis=-1)
    log_f = jnp.logaddexp(jnp.log(lb), jnp.log1p(-lb) + jax.nn.log_sigmoid(f.astype(f32)))
    k = -jnp.expm1(log_f)
    q = jax.nn.silu(q.astype(f32))
    v = i.astype(f32)

    def to_chunks(t, dh):
        return t.reshape(bsz, n_chunks, A_CHUNK, A_HEADS, dh).transpose(1, 0, 3, 2, 4)

    qc, kc, gc = (to_chunks(t, A_KEY_DIM) for t in (q, k, log_f))
    vc = to_chunks(v, A_VAL_DIM)
    causal = jnp.tril(jnp.ones((A_CHUNK, A_CHUNK), dtype=bool))

    def step(state, inp):
        qb, kb, vb, gb = inp
        cum = jnp.cumsum(gb, axis=2)
        rel = cum[:, :, :, None, :] - cum[:, :, None, :, :]
        decay = jnp.exp(jnp.where(causal[:, :, None], rel, -jnp.inf))
        scores = jnp.einsum('bhtd,bhtsd,bhsd->bhts', qb, decay, kb)
        out = (jnp.einsum('bhts,bhse->bhte', scores, vb)
               + jnp.einsum('bhtd,bhde->bhte', qb * jnp.exp(cum), state))
        last = cum[:, :, -1, :]
        state = (jnp.exp(last)[..., None] * state
                 + jnp.einsum('bhsd,bhse->bhde', kb * jnp.exp(last[:, :, None, :] - cum), vb))
        return state, out

    state0 = jnp.zeros((bsz, A_HEADS, A_KEY_DIM, A_VAL_DIM), f32)
    _, o = lax.scan(step, state0, (qc, kc, vc, gc))
    o = o.transpose(1, 0, 3, 2, 4).reshape(bsz, seq, A_HEADS, A_VAL_DIM)
    o = _rms(o, out_gain) * jax.nn.silu(g.astype(f32)).reshape(bsz, seq, A_HEADS, A_VAL_DIM)
    return o.reshape(bsz, seq, A_VAL_WIDTH).astype(h.dtype) @ w_out


def _t5_bucket(dist):
    dist = np.asarray(dist, np.int32)
    max_exact = NUM_BUCKETS // 2
    large = max_exact + (np.log(np.maximum(dist, 1) / max_exact)
                         / math.log(MAX_DISTANCE / max_exact) * (NUM_BUCKETS - max_exact)).astype(np.int32)
    large = np.minimum(large, NUM_BUCKETS - 1)
    return np.where(dist < max_exact, dist, large).astype(np.int32)


def _band_static(window, dilation):
    nq = B_BLOCK // dilation
    wd = window // dilation
    nj = wd + nq
    m = np.arange(nj)[None, :] - np.arange(nq)[:, None]
    band = (m >= 0) & (m <= wd)
    bucket = _t5_bucket((wd - np.clip(m, 0, wd)) * dilation)
    return band, bucket


def _shared_kv(x, kv_norm, w_kv, k_gain):
    bsz, seq, _ = x.shape
    kv = (_rms(x, kv_norm) @ w_kv).reshape(bsz, seq, 2, B_GROUPS, B_HEADS, B_HEAD_DIM)
    k = _rms(kv[:, :, 0], k_gain[:, None, :])
    v = kv[:, :, 1]
    k_pads = [jnp.pad(k[:, :, g], ((0, 0), (w, 0), (0, 0), (0, 0))) for g, w in enumerate(B_WINDOWS)]
    v_pads = [jnp.pad(v[:, :, g], ((0, 0), (w, 0), (0, 0), (0, 0))) for g, w in enumerate(B_WINDOWS)]
    return k_pads, v_pads


def _dilated_attention(h, w_q, q_gain, w_o, k_pads, v_pads, rel_bias):
    bsz, seq, _ = h.shape
    n_blocks = seq // B_BLOCK
    f32 = jnp.float32
    q = (h @ w_q).reshape(bsz, seq, B_GROUPS, B_HEADS, B_HEAD_DIM)
    q = _rms(q, q_gain[:, None, :]) * (B_HEAD_DIM ** -0.5)
    q_groups = [q[:, :, g] for g in range(B_GROUPS)]
    statics = [_band_static(w, d) for w, d in zip(B_WINDOWS, B_DILATIONS)]
    biases = [rel_bias[bucket][..., g * B_HEADS:(g + 1) * B_HEADS].transpose(2, 0, 1).astype(f32)
              for g, (_, bucket) in enumerate(statics)]

    def block(b):
        start = b * B_BLOCK
        outs, lses = [], []
        for g, (window, dil) in enumerate(zip(B_WINDOWS, B_DILATIONS)):
            band = statics[g][0]
            nq = B_BLOCK // dil
            nj = window // dil + nq
            qb = lax.dynamic_slice_in_dim(q_groups[g], start, B_BLOCK, axis=1).reshape(bsz, nq, dil, B_HEADS, B_HEAD_DIM)
            kb = lax.dynamic_slice_in_dim(k_pads[g], start, window + B_BLOCK, axis=1).reshape(bsz, nj, dil, B_HEADS, B_HEAD_DIM)
            vb = lax.dynamic_slice_in_dim(v_pads[g], start, window + B_BLOCK, axis=1).reshape(bsz, nj, dil, B_HEADS, B_HEAD_DIM)
            s = jnp.einsum('birhd,bjrhd->bhrij', qb, kb).astype(f32) + biases[g][None, :, None]
            pos = start - window + jnp.arange(nj)[:, None] * dil + jnp.arange(dil)[None, :]
            valid = band[None, :, :] & (pos.T >= 0)[:, None, :]
            s = jnp.where(valid[None, None], s, -jnp.inf)
            lse = jax.nn.logsumexp(s, axis=-1)
            p = jnp.exp(s - lse[..., None]).astype(vb.dtype)
            o = jnp.einsum('bhrij,bjrhd->birhd', p, vb).reshape(bsz, B_BLOCK, B_HEADS, B_HEAD_DIM)
            outs.append(o.astype(f32))
            lses.append(lse.transpose(0, 3, 2, 1).reshape(bsz, B_BLOCK, B_HEADS))
        wts = jax.nn.softmax(jnp.stack(lses), axis=0)
        o = jnp.einsum('gbqh,gbqhd->bqhd', wts, jnp.stack(outs))
        return o.reshape(bsz, B_BLOCK, B_HEADS * B_HEAD_DIM).astype(h.dtype)

    o = lax.map(block, jnp.arange(n_blocks))
    o = o.transpose(1, 0, 2, 3).reshape(bsz, seq, B_HEADS * B_HEAD_DIM)
    return o @ w_o


def setup_inputs(seed: int = 0) -> dict:
    key = jax.random.key(seed)
    ks = jax.random.split(key, 16)

    def dense(k, shape, fan_in):
        return jax.random.normal(k, shape, jnp.float32) * fan_in ** -0.5

    def gain(k, shape):
        return 1.0 + 0.1 * jax.random.normal(k, shape, jnp.float32)

    return {
        'x': jax.random.normal(ks[0], (BATCH, SEQ, D_MODEL), jnp.float32),
        'norm_gain': gain(ks[1], (DEPTH, 3, D_MODEL)),
        'ffn_w_in': dense(ks[2], (DEPTH, 2, D_MODEL, 2 * D_FF), D_MODEL),
        'ffn_w_out': dense(ks[3], (DEPTH, 2, D_FF, D_MODEL), D_FF),
        'a_w_in': dense(ks[4], (N_A_LAYERS, D_MODEL, A_IN_WIDTH), D_MODEL),
        'a_lb_logits': 0.5 * jax.random.normal(ks[5], (N_A_LAYERS + 1, A_FORGET_DIM), jnp.float32),
        'a_out_gain': gain(ks[6], (N_A_LAYERS, A_VAL_DIM)),
        'a_w_out': dense(ks[7], (N_A_LAYERS, A_VAL_WIDTH, D_MODEL), A_VAL_WIDTH),
        'kv_norm': gain(ks[8], (D_MODEL,)),
        'w_kv': dense(ks[9], (D_MODEL, 2 * B_QKV_WIDTH), D_MODEL),
        'k_gain': gain(ks[10], (B_GROUPS, B_HEAD_DIM)),
        'b_w_q': dense(ks[11], (N_B_LAYERS, D_MODEL, B_QKV_WIDTH), D_MODEL),
        'b_q_gain': gain(ks[12], (N_B_LAYERS, B_GROUPS, B_HEAD_DIM)),
        'b_w_o': dense(ks[13], (N_B_LAYERS, B_HEADS * B_HEAD_DIM, D_MODEL), B_HEADS * B_HEAD_DIM),
        'rel_bias': 0.5 * jax.random.normal(ks[14], (NUM_BUCKETS, B_GROUPS * B_HEADS), jnp.float32),
    }


def reference(x, norm_gain, ffn_w_in, ffn_w_out, a_w_in, a_lb_logits, a_out_gain, a_w_out,
              kv_norm, w_kv, k_gain, b_w_q, b_q_gain, b_w_o, rel_bias):
    lower_bounds = _lower_bounds(a_lb_logits)
    k_pads, v_pads = None, None
    for layer in range(DEPTH):
        if layer == N_A_LAYERS:
            k_pads, v_pads = _shared_kv(x, kv_norm, w_kv, k_gain)
        x = x + 0.5 * _swiglu(_rms(x, norm_gain[layer, 0]), ffn_w_in[layer, 0], ffn_w_out[layer, 0])
        h = _rms(x, norm_gain[layer, 1])
        if layer < N_A_LAYERS:
            x = x + _hgrn2(h, a_w_in[layer], lower_bounds[layer], a_out_gain[layer], a_w_out[layer])
        else:
            j = layer - N_A_LAYERS
            x = x + _dilated_attention(h, b_w_q[j], b_q_gain[j], b_w_o[j], k_pads, v_pads, rel_bias)
        x = x + 0.5 * _swiglu(_rms(x, norm_gain[layer, 2]), ffn_w_in[layer, 1], ffn_w_out[layer, 1])
    return x
```

```cpp
#include <hip/hip_runtime.h>
#include <hip/hip_cooperative_groups.h>
#include <cstdio>
#include <cstdint>
namespace cg = cooperative_groups;
namespace pg8 {
#define PG8_LAS __attribute__((address_space(3)))
typedef unsigned short bf16_t;
typedef short bf16x8 __attribute__((ext_vector_type(8)));
typedef float f32x4 __attribute__((ext_vector_type(4)));
typedef unsigned u32x4 __attribute__((ext_vector_type(4)));
constexpr int BM = 256, BK = 64, HALF = 128, HTB = HALF * BK * 2  , STAGE_BYTES = 8 * HTB, NXCD = 8, WGM = 8;

__host__ __device__ __forceinline__ int lds_byte(int r, int c) { const int st = (r >> 4) * 2 + (c >> 5), rr = r & 15, cc = c & 31, ob = rr * 64 + cc * 2; return st * 1024 + (ob ^ (((ob >> 9) & 1) << 5)); }
__host__ __device__ __forceinline__ void stage_rc(int b, int& R, int& C) { const int st = b / 1024, sb = b % 1024, swz = sb ^ (((sb >> 9) & 1) << 5); R = (st >> 1) * 16 + swz / 64; C = (st & 1) * 32 + (swz % 64) / 2; }
__host__ __device__ __forceinline__ int perm32(int rho) { const int n = rho >> 4, i = rho & 15; return 8 * (i >> 2) + 4 * n + (i & 3); }

struct Unit { int pm, pn; };
struct Gemm { const bf16_t* A; const bf16_t* Bt; int M, N, K; };

struct StaticOrder {
    int nM, nN, nwg, G, c;
    __host__ __device__ void init(int M, int N, int G_, int c_) { nM = M / BM; nN = N / BM; nwg = nM * nN; G = G_; c = c_; }
    __host__ __device__ bool next(int i, Unit& u) const {
        const long L = (long)i * G + c; if (L >= nwg) return false;
        int wgid = (int)L; { const int q = nwg / NXCD, r = nwg % NXCD, xcd = wgid % NXCD, off = wgid / NXCD; wgid = (xcd < r ? xcd * (q + 1) : r * (q + 1) + (xcd - r) * q) + off; }
        const int nig = WGM * nN, gid = wgid / nig, fm = gid * WGM, gsz = (nM - fm) < WGM ? (nM - fm) : WGM;
        u.pm = fm + ((wgid % nig) % gsz); u.pn = (wgid % nig) / gsz; return true;
    }
    __device__ __forceinline__ void a_ready(const Unit&) const {}
    __device__ __forceinline__ void done(const Unit&) const {}
};

typedef float f32x2c_t __attribute__((ext_vector_type(2))); typedef __bf16 bf16x2c_t __attribute__((ext_vector_type(2)));
__device__ __forceinline__ unsigned cvt_pk_bf16(float lo, float hi) { const f32x2c_t v = {lo, hi}; const bf16x2c_t b = __builtin_convertvector(v, bf16x2c_t); return __builtin_bit_cast(unsigned, b); }
typedef float f32x2 __attribute__((ext_vector_type(2)));

__device__ __forceinline__ float silu_f(float x) { return x * __builtin_amdgcn_rcpf(1.0f + __expf(-x)); }

struct EpiBf16 {
    static constexpr bool PERM = true, AFTER_DRAIN = false;
    bf16_t* O; int ldc; int sh;
    __device__ __forceinline__ void operator()(const f32x4 (&acc)[2][2][4][2], const Unit& u, int wr, int wc, int fr, int fq) const {
        const int row0 = u.pm * BM + wr * 64 + fr; const int t = u.pn >> 2; const int col0 = (u.pn & 3) * BM + wc * 32 + 8 * fq;
        bf16_t* Ot = O + (size_t)t * 32768 * 1024;
#pragma unroll
        for (int ai = 0; ai < 2; ++ai)
#pragma unroll
            for (int m = 0; m < 4; ++m) { const int row = row0 + ai * HALF + m * 16;
                const int bb = row >> 14, s = row & 16383; const int prow = sh < 0 ? 0 : (((s & ((1 << sh) - 1)) << (14 - sh)) | (s >> sh));
#pragma unroll
                for (int bj = 0; bj < 2; ++bj) { const f32x4 v0 = acc[ai][bj][m][0], v1 = acc[ai][bj][m][1]; const int col = col0 + bj * HALF;
                    u32x4 w; w.x = cvt_pk_bf16(v0[0], v0[1]); w.y = cvt_pk_bf16(v0[2], v0[3]); w.z = cvt_pk_bf16(v1[0], v1[1]); w.w = cvt_pk_bf16(v1[2], v1[3]);
                    bf16_t* dst = sh < 0 ? Ot + (size_t)row * ldc + col : Ot + ((((size_t)(bb * 16 + (col >> 6))) << 14) + prow) * 64 + (col & 63);
                    *(u32x4*)dst = w; } }
    }
};

struct EpiSwiglu {
    static constexpr bool PERM = true, AFTER_DRAIN = false;
    bf16_t* H;
    __device__ __forceinline__ void operator()(const f32x4 (&acc)[2][2][4][2], const Unit& u, int wr, int wc, int fr, int fq) const {
        const int row0 = u.pm * BM + wr * 64 + fr; const int col0 = u.pn * HALF + wc * 32 + 8 * fq;
#pragma unroll
        for (int ai = 0; ai < 2; ++ai)
#pragma unroll
            for (int m = 0; m < 4; ++m) { bf16_t* rowp = H + (size_t)(row0 + ai * HALF + m * 16) * 2816 + col0;
                const f32x4 g0 = acc[ai][0][m][0], g1 = acc[ai][0][m][1], u0 = acc[ai][1][m][0], u1 = acc[ai][1][m][1];
                float h[8];
#pragma unroll
                for (int j = 0; j < 4; ++j) { h[j] = silu_f(g0[j]) * u0[j]; h[4 + j] = silu_f(g1[j]) * u1[j]; }
                u32x4 w; w.x = cvt_pk_bf16(h[0], h[1]); w.y = cvt_pk_bf16(h[2], h[3]); w.z = cvt_pk_bf16(h[4], h[5]); w.w = cvt_pk_bf16(h[6], h[7]);
                *(u32x4*)rowp = w; }
    }
};

struct EpiResid {
    static constexpr bool PERM = true, AFTER_DRAIN = false;
    const float* res; float* out; float scale;
    __device__ __forceinline__ void operator()(const f32x4 (&acc)[2][2][4][2], const Unit& u, int wr, int wc, int fr, int fq) const {
        const int row0 = u.pm * BM + wr * 64 + fr; const int col0 = u.pn * BM + wc * 32 + 8 * fq;
#pragma unroll
        for (int ai = 0; ai < 2; ++ai)
#pragma unroll
            for (int m = 0; m < 4; ++m) { const size_t off = (size_t)(row0 + ai * HALF + m * 16) * 1024 + col0;
#pragma unroll
                for (int bj = 0; bj < 2; ++bj) {
                    const f32x4 r0 = *(const f32x4*)(res + off + bj * HALF), r1 = *(const f32x4*)(res + off + bj * HALF + 4);
                    __builtin_nontemporal_store(r0 + acc[ai][bj][m][0] * scale, (f32x4*)(out + off + bj * HALF)); __builtin_nontemporal_store(r1 + acc[ai][bj][m][1] * scale, (f32x4*)(out + off + bj * HALF + 4));   } }
    }
};


template <class BarFn, size_t OSSP, size_t OXN, size_t OXN3> struct EpiResidNorm {
    static constexpr bool PERM = true, AFTER_DRAIN = true;
    const float* res; float* out; unsigned char* ws; const float* g1; const float* g2; unsigned* barw; float scale; int row_off; int dual; unsigned bst;
    __device__ __forceinline__ void fused(f32x4 (&acc)[2][2][4][2], const Unit& u, int wr, int wc, int fr, int fq, PG8_LAS unsigned char* lds, int wid, int lane) const {
        const int row0 = row_off + u.pm * BM + wr * 64 + fr; const int col0 = u.pn * BM + wc * 32 + 8 * fq;
        float* SSP = (float*)(ws + OSSP);
#pragma unroll
        for (int ai = 0; ai < 2; ++ai)
#pragma unroll
            for (int m = 0; m < 4; ++m) { const size_t off = (size_t)(row0 + ai * HALF + m * 16) * 1024 + col0; float ss = 0.f;
#pragma unroll
                for (int bj = 0; bj < 2; ++bj) {
                    const f32x4 r0 = *(const f32x4*)(res + off + bj * HALF), r1 = *(const f32x4*)(res + off + bj * HALF + 4);
                    const f32x4 x0 = r0 + acc[ai][bj][m][0] * scale, x1 = r1 + acc[ai][bj][m][1] * scale;
                    acc[ai][bj][m][0] = x0; acc[ai][bj][m][1] = x1;
                    ss += ((x0[0] * x0[0] + x0[1] * x0[1]) + (x0[2] * x0[2] + x0[3] * x0[3])) + ((x1[0] * x1[0] + x1[1] * x1[1]) + (x1[2] * x1[2] + x1[3] * x1[3])); }
                ss += __shfl_xor(ss, 16); ss += __shfl_xor(ss, 32);
                if (fq == 0) SSP[(size_t)(row0 + ai * HALF + m * 16) * 16 + u.pn * 4 + wc] = ss;
                if (m & 1) asm volatile("" ::: "memory"); }
        BarFn::sync(barw, bst);
        f32x4 ga[2][2], gb[2][2];
#pragma unroll
        for (int bj = 0; bj < 2; ++bj) { ga[bj][0] = *(const f32x4*)(g1 + col0 + bj * HALF); ga[bj][1] = *(const f32x4*)(g1 + col0 + bj * HALF + 4);
            gb[bj][0] = dual ? *(const f32x4*)(g2 + col0 + bj * HALF) : ga[bj][0]; gb[bj][1] = dual ? *(const f32x4*)(g2 + col0 + bj * HALF + 4) : ga[bj][1]; }
        bf16_t* XN = (bf16_t*)(ws + OXN); bf16_t* XN3 = (bf16_t*)(ws + OXN3);
#pragma unroll
        for (int ai = 0; ai < 2; ++ai)
#pragma unroll
            for (int m = 0; m < 4; ++m) { const int row = row0 + ai * HALF + m * 16; const size_t off = (size_t)row * 1024 + col0;
                const f32x4* sp = (const f32x4*)(SSP + (size_t)row * 16); const f32x4 pa = sp[0], pb = sp[1], pc = sp[2], pd = sp[3];
                const float s = (((pa[0] + pa[1]) + (pa[2] + pa[3])) + ((pb[0] + pb[1]) + (pb[2] + pb[3]))) + (((pc[0] + pc[1]) + (pc[2] + pc[3])) + ((pd[0] + pd[1]) + (pd[2] + pd[3])));
                const float rstd = rsqrtf(s * (1.0f / 1024.0f) + 1e-6f);
#pragma unroll
                for (int bj = 0; bj < 2; ++bj) { const f32x4 x0 = acc[ai][bj][m][0], x1 = acc[ai][bj][m][1];
                    __builtin_nontemporal_store(x0, (f32x4*)(out + off + bj * HALF)); __builtin_nontemporal_store(x1, (f32x4*)(out + off + bj * HALF + 4));
                    const f32x4 y0 = x0 * rstd, y1 = x1 * rstd; const f32x4 a0 = y0 * ga[bj][0], a1 = y1 * ga[bj][1];
                    u32x4 w; w.x = cvt_pk_bf16(a0[0], a0[1]); w.y = cvt_pk_bf16(a0[2], a0[3]); w.z = cvt_pk_bf16(a1[0], a1[1]); w.w = cvt_pk_bf16(a1[2], a1[3]);
                    *(u32x4*)(XN + off + bj * HALF) = w;
                    if (dual) { const f32x4 b0 = y0 * gb[bj][0], b1 = y1 * gb[bj][1];
                        u32x4 w2; w2.x = cvt_pk_bf16(b0[0], b0[1]); w2.y = cvt_pk_bf16(b0[2], b0[3]); w2.z = cvt_pk_bf16(b1[0], b1[1]); w2.w = cvt_pk_bf16(b1[2], b1[3]);
                        __builtin_nontemporal_store(w2, (u32x4*)(XN3 + off + bj * HALF));   } }
                if (m & 1) asm volatile("" ::: "memory"); }
    }
};

__device__ __forceinline__ float lbf(float l0, float l1) { return __builtin_amdgcn_rcpf(1.0f + __expf(l1 - l0)); }
__device__ __forceinline__ float lff(float lb, float z) { return __log2f(lb + (1.0f - lb) * __builtin_amdgcn_rcpf(1.0f + __expf(-z))); }
template <size_t OQ, size_t OLF, size_t OV, size_t OG> struct EpiAin {
    static constexpr bool PERM = true, AFTER_DRAIN = false;
    unsigned char* ws; const float* lbl;
    __device__ __forceinline__ void operator()(const f32x4 (&acc)[2][2][4][2], const Unit& u, int wr, int wc, int fr, int fq) const {
        const int type = u.pn >> 2; const int row0 = u.pm * BM + wr * 64 + fr; const int col0 = (u.pn & 3) * BM + wc * 32 + 8 * fq;
        if (type == 1) {
#pragma unroll
            for (int bj = 0; bj < 2; ++bj) { const int c = col0 + bj * HALF;
                const f32x4 la0 = *(const f32x4*)(lbl + c), la1 = *(const f32x4*)(lbl + c + 4), lc0 = *(const f32x4*)(lbl + 1024 + c), lc1 = *(const f32x4*)(lbl + 1024 + c + 4);
                f32x4 lb0, lb1;
                lb0.x = lbf(la0.x, lc0.x); lb0.y = lbf(la0.y, lc0.y); lb0.z = lbf(la0.z, lc0.z); lb0.w = lbf(la0.w, lc0.w);
                lb1.x = lbf(la1.x, lc1.x); lb1.y = lbf(la1.y, lc1.y); lb1.z = lbf(la1.z, lc1.z); lb1.w = lbf(la1.w, lc1.w);
#pragma unroll
                for (int ai = 0; ai < 2; ++ai)
#pragma unroll
                    for (int m = 0; m < 4; ++m) { float* rowp = (float*)(ws + OLF) + (size_t)(row0 + ai * HALF + m * 16) * 1024 + c;
                        const f32x4 z0 = acc[ai][bj][m][0], z1 = acc[ai][bj][m][1]; f32x4 o0, o1;
                        o0.x = lff(lb0.x, z0.x); o0.y = lff(lb0.y, z0.y); o0.z = lff(lb0.z, z0.z); o0.w = lff(lb0.w, z0.w);
                        o1.x = lff(lb1.x, z1.x); o1.y = lff(lb1.y, z1.y); o1.z = lff(lb1.z, z1.z); o1.w = lff(lb1.w, z1.w);
                        *(f32x4*)rowp = o0; *(f32x4*)(rowp + 4) = o1; } }
        } else {
            bf16_t* base = (bf16_t*)(ws + (type == 0 ? OQ : (type == 2 ? OV : OG))); const bool act = type != 2;
#pragma unroll
            for (int ai = 0; ai < 2; ++ai)
#pragma unroll
                for (int m = 0; m < 4; ++m) { bf16_t* rowp = base + (size_t)(row0 + ai * HALF + m * 16) * 1024 + col0;
#pragma unroll
                    for (int bj = 0; bj < 2; ++bj) { f32x4 v0 = acc[ai][bj][m][0], v1 = acc[ai][bj][m][1];
                        if (act) {
#pragma unroll
                            for (int j = 0; j < 4; ++j) { v0[j] = silu_f(v0[j]); v1[j] = silu_f(v1[j]); } }
                        u32x4 w; w.x = cvt_pk_bf16(v0[0], v0[1]); w.y = cvt_pk_bf16(v0[2], v0[3]); w.z = cvt_pk_bf16(v1[0], v1[1]); w.w = cvt_pk_bf16(v1[2], v1[3]);
                        if (act) __builtin_nontemporal_store(w, (u32x4*)(rowp + bj * HALF)); else *(u32x4*)(rowp + bj * HALF) = w; } }
        }
    }
};

template <class Epi, class Sched, bool ALIGN_EPI = false, bool SP2 = false>
__device__ __forceinline__ void gemm_phase(PG8_LAS unsigned char* lds, const Gemm g, const Sched& S, const Epi& E) {
    int tid = threadIdx.x; asm volatile("" : "+v"(tid));
    const int wid = __builtin_amdgcn_readfirstlane(tid >> 6), lane = tid & 63, wr = wid >> 2, wc = wid & 3, fr = lane & 15, fq = lane >> 4;
    const int K = g.K, nt = K / BK;
    unsigned voffA[2], voffB[2];
#pragma unroll
    for (int i = 0; i < 2; ++i) { int R, C; stage_rc(tid * 16 + i * 8192, R, C); const int Rb = Epi::PERM ? ((R & ~31) + perm32(R & 31)) : R;
        voffA[i] = (unsigned)(R * K + C) * 2u; voffB[i] = (unsigned)(Rb * K + C) * 2u; }
    const size_t kstep = (size_t)(BK * 2);
    const size_t hstep = (size_t)HALF * K * 2;
    const size_t tstep = 2 * hstep;
    const unsigned ldsw = (unsigned)wid * 1024u;
    const int aoff = lds_byte(wr * 64 + fr, fq * 8), boff = lds_byte(wc * 32 + fr, fq * 8);
#define PG8_SA(b, h) (((b) * 2 + (h)) * HTB)
#define PG8_SB(b, h) ((4 + (b) * 2 + (h)) * HTB)
#define PG8_STAGE(bufoff, gbase, voff) do { _Pragma("unroll") for (int _i = 0; _i < 2; ++_i) \
        __builtin_amdgcn_global_load_lds((const unsigned*)((const char*)(gbase) + (voff)[_i]), (PG8_LAS unsigned*)(lds + (bufoff) + ldsw + _i * 8192), 16, 0, 0); } while (0)
#define PG8_LDA(dst, b, h) do { _Pragma("unroll") for (int m = 0; m < 4; ++m) _Pragma("unroll") for (int k = 0; k < 2; ++k) dst[m][k] = *(const PG8_LAS bf16x8*)(lds + PG8_SA(b, h) + aoff + m * 2048 + k * 1024); } while (0)
#define PG8_LDB(dst, b, h) do { _Pragma("unroll") for (int n = 0; n < 2; ++n) _Pragma("unroll") for (int k = 0; k < 2; ++k) dst[n][k] = *(const PG8_LAS bf16x8*)(lds + PG8_SB(b, h) + boff + n * 2048 + k * 1024); } while (0)
#define PG8_MMA(ai, bj, At, Bt) do { __builtin_amdgcn_s_setprio(1); _Pragma("unroll") for (int m = 0; m < 4; ++m) _Pragma("unroll") for (int n = 0; n < 2; ++n) _Pragma("unroll") for (int k = 0; k < 2; ++k) \
        acc[ai][bj][m][n] = __builtin_amdgcn_mfma_f32_16x16x32_bf16(Bt[n][k], At[m][k], acc[ai][bj][m][n], 0, 0, 0); __builtin_amdgcn_s_setprio(0); } while (0)
#define PG8_WAIT_V(n) asm volatile("s_waitcnt vmcnt(" #n ")" ::: "memory")
#define PG8_WAIT_L(n) asm volatile("s_waitcnt lgkmcnt(" #n ")" ::: "memory")
#define PG8_BAR __builtin_amdgcn_s_barrier()
#define PG8_SCHED __builtin_amdgcn_sched_barrier(0)
    Unit cur, nxt; int ui = 0;
    if (!S.next(0, cur)) return;
    f32x4 acc[2][2][4][2];
#pragma unroll
    for (int a = 0; a < 2; ++a)
#pragma unroll
        for (int b = 0; b < 2; ++b)
#pragma unroll
            for (int m = 0; m < 4; ++m)
#pragma unroll
                for (int n = 0; n < 2; ++n) acc[a][b][m][n] = (f32x4){0.f, 0.f, 0.f, 0.f};
    bf16x8 At[4][2], B0[2][2], B1[2][2];
    const char* cA = (const char*)g.A + (size_t)cur.pm * tstep; const char* cB = (const char*)g.Bt + (size_t)cur.pn * tstep;
    S.a_ready(cur);
    if constexpr (SP2) {
        PG8_STAGE(PG8_SB(0, 0), cB, voffB); PG8_STAGE(PG8_SB(0, 1), cB + hstep, voffB); PG8_STAGE(PG8_SA(0, 0), cA, voffA); PG8_STAGE(PG8_SA(0, 1), cA + hstep, voffA);
        if (wr == 1) PG8_BAR;
        PG8_WAIT_V(2); PG8_BAR;
        PG8_STAGE(PG8_SB(1, 0), cB + kstep, voffB); PG8_STAGE(PG8_SA(1, 0), cA + kstep, voffA); PG8_STAGE(PG8_SB(1, 1), cB + hstep + kstep, voffB);
        PG8_WAIT_V(6); PG8_BAR;
    } else {
        PG8_STAGE(PG8_SB(0, 0), cB, voffB); PG8_STAGE(PG8_SA(0, 0), cA, voffA); PG8_STAGE(PG8_SB(0, 1), cB + hstep, voffB); PG8_STAGE(PG8_SA(0, 1), cA + hstep, voffA);
        if (wr == 1) PG8_BAR;
        PG8_WAIT_V(4); PG8_BAR;
        PG8_STAGE(PG8_SB(1, 0), cB + kstep, voffB); PG8_STAGE(PG8_SA(1, 0), cA + kstep, voffA); PG8_STAGE(PG8_SB(1, 1), cB + hstep + kstep, voffB);
        PG8_WAIT_V(6); PG8_BAR;
    }
    for (;;) {
        const bool has_next = S.next(ui + 1, nxt);
        const char* nA = has_next ? (const char*)g.A + (size_t)nxt.pm * tstep : cA; const char* nB = has_next ? (const char*)g.Bt + (size_t)nxt.pn * tstep : cB;
        for (int t = 0; t < nt; t += 2) {
            const bool last = (t == nt - 2);
            const char* a1 = cA + (size_t)(t + 1) * kstep;
            const char* a2 = last ? nA : cA + (size_t)(t + 2) * kstep; const char* b2 = last ? nB : cB + (size_t)(t + 2) * kstep;
            const char* a3 = a2 + kstep; const char* b3 = b2 + kstep;
            if (last && has_next) S.a_ready(nxt);
            if constexpr (SP2) {
            PG8_LDB(B0, 0, 0); PG8_LDB(B1, 0, 1); PG8_SCHED; PG8_LDA(At, 0, 0); PG8_STAGE(PG8_SA(1, 1), a1 + hstep, voffA);
            PG8_WAIT_V(8); PG8_WAIT_L(0); PG8_BAR; PG8_MMA(0, 0, At, B0); PG8_MMA(0, 1, At, B1); PG8_BAR; PG8_SCHED;
            PG8_LDA(At, 0, 1); PG8_STAGE(PG8_SB(0, 0), b2, voffB); PG8_STAGE(PG8_SB(0, 1), b2 + hstep, voffB); PG8_STAGE(PG8_SA(0, 0), a2, voffA);
            PG8_WAIT_V(8); PG8_WAIT_L(0); PG8_BAR; PG8_MMA(1, 0, At, B0); PG8_MMA(1, 1, At, B1); PG8_BAR; PG8_SCHED;
            PG8_LDB(B0, 1, 0); PG8_LDB(B1, 1, 1); PG8_SCHED; PG8_LDA(At, 1, 0); PG8_STAGE(PG8_SA(0, 1), a2 + hstep, voffA);
            PG8_WAIT_V(8); PG8_WAIT_L(0); PG8_BAR; PG8_MMA(0, 0, At, B0); PG8_MMA(0, 1, At, B1); PG8_BAR; PG8_SCHED;
            PG8_LDA(At, 1, 1); PG8_STAGE(PG8_SB(1, 0), b3, voffB); PG8_STAGE(PG8_SB(1, 1), b3 + hstep, voffB); PG8_STAGE(PG8_SA(1, 0), a3, voffA);
            PG8_WAIT_V(8); PG8_WAIT_L(0); PG8_BAR; PG8_MMA(1, 0, At, B0); PG8_MMA(1, 1, At, B1); PG8_BAR; PG8_SCHED;
            } else {
            PG8_LDB(B0, 0, 0); PG8_SCHED; PG8_LDA(At, 0, 0); PG8_STAGE(PG8_SA(1, 1), a1 + hstep, voffA);
            PG8_WAIT_L(8); PG8_BAR; PG8_WAIT_L(0); PG8_MMA(0, 0, At, B0); PG8_BAR; PG8_SCHED;
            PG8_LDB(B1, 0, 1); PG8_STAGE(PG8_SB(0, 0), b2, voffB);
            PG8_BAR; PG8_WAIT_L(0); PG8_MMA(0, 1, At, B1); PG8_BAR;
            PG8_LDA(At, 0, 1); PG8_STAGE(PG8_SA(0, 0), a2, voffA);
            PG8_BAR; PG8_WAIT_L(0); PG8_MMA(1, 0, At, B0); PG8_BAR; PG8_SCHED;
            PG8_STAGE(PG8_SB(0, 1), b2 + hstep, voffB);
            PG8_WAIT_V(6); PG8_BAR; PG8_MMA(1, 1, At, B1); PG8_BAR;
            PG8_LDB(B0, 1, 0); PG8_SCHED; PG8_LDA(At, 1, 0); PG8_STAGE(PG8_SA(0, 1), a2 + hstep, voffA);
            PG8_WAIT_L(8); PG8_BAR; PG8_WAIT_L(0); PG8_MMA(0, 0, At, B0); PG8_BAR; PG8_SCHED;
            PG8_LDB(B1, 1, 1); PG8_STAGE(PG8_SB(1, 0), b3, voffB);
            PG8_BAR; PG8_WAIT_L(0); PG8_MMA(0, 1, At, B1); PG8_BAR;
            PG8_LDA(At, 1, 1); PG8_STAGE(PG8_SA(1, 0), a3, voffA);
            PG8_BAR; PG8_WAIT_L(0); PG8_MMA(1, 0, At, B0); PG8_BAR; PG8_SCHED;
            PG8_STAGE(PG8_SB(1, 1), b3 + hstep, voffB);
            PG8_WAIT_V(6); PG8_BAR; PG8_MMA(1, 1, At, B1); PG8_BAR;
            }
        }
        if constexpr (ALIGN_EPI) { if (wr == 0) PG8_BAR; }
        if constexpr (!Epi::AFTER_DRAIN) { E(acc, cur, wr, wc, fr, fq); S.done(cur); }
        if (!has_next) break;
#pragma unroll
        for (int a = 0; a < 2; ++a)
#pragma unroll
            for (int b = 0; b < 2; ++b)
#pragma unroll
                for (int m = 0; m < 4; ++m)
#pragma unroll
                    for (int n = 0; n < 2; ++n) acc[a][b][m][n] = (f32x4){0.f, 0.f, 0.f, 0.f};
        cur = nxt; cA = nA; cB = nB; ++ui;
        if constexpr (ALIGN_EPI) { if (wr == 1) PG8_BAR; }
    }
    PG8_WAIT_V(0);
    if constexpr (!ALIGN_EPI) { if (wr == 0) PG8_BAR; }
    PG8_BAR;
    if constexpr (Epi::AFTER_DRAIN) { E.fused(acc, cur, wr, wc, fr, fq, lds, wid, lane); S.done(cur); }
#undef PG8_SA
#undef PG8_SB
#undef PG8_STAGE
#undef PG8_LDA
#undef PG8_LDB
#undef PG8_MMA
#undef PG8_WAIT_V
#undef PG8_WAIT_L
#undef PG8_BAR
#undef PG8_SCHED
}
}

constexpr int BATCH = 2, SEQ = 16384, DM = 1024, DFF = 2816, MTOK = BATCH * SEQ;
constexpr int NCHUNK = SEQ / 64;
constexpr float EPS = 1e-6f;
constexpr float LOG2E = 1.4426950408889634f, LN2 = 0.6931471805599453f;
constexpr size_t MiB = 1u << 20;
constexpr size_t WS_WIN0 = 1 * MiB, WS_WIN1 = 12 * MiB, WS_WOUT0 = 23 * MiB, WS_WOUT1 = 23 * MiB + 5767168, WS_WAIN = 34 * MiB, WS_WAOUT = 42 * MiB;
constexpr size_t WS_XN = 44 * MiB, WS_XN3 = 108 * MiB;
constexpr size_t WS_ST = 44 * MiB;
constexpr size_t WS_QH = 172 * MiB;
constexpr size_t WS_VH = 236 * MiB, WS_GH = 300 * MiB, WS_LF = 364 * MiB;
constexpr size_t WS_DC = 492 * MiB, WS_LSE = 494 * MiB, WS_SSP = 496 * MiB, WS_END = 498 * MiB;
constexpr size_t WS_WIN2 = 236 * MiB, WS_WIN3 = 247 * MiB, WS_WOUT2 = 258 * MiB, WS_WOUT3 = 258 * MiB + 5767168, WS_WKV = 269 * MiB, WS_WQ = 281 * MiB, WS_WO = 287 * MiB;
constexpr size_t WS_H = 289 * MiB;
constexpr size_t WS_QG = 289 * MiB, WS_KG = 353 * MiB, WS_VG = 417 * MiB;
constexpr size_t WS_BAR = 65536;
constexpr int LDS_BYTES = 155648;

#define LAS __attribute__((address_space(3)))
typedef unsigned short bf16;
typedef unsigned v4u __attribute__((ext_vector_type(4)));
typedef unsigned v2u __attribute__((ext_vector_type(2)));
typedef float f32x4 __attribute__((ext_vector_type(4)));
#define LDS_WAIT() asm volatile("s_waitcnt lgkmcnt(0)" ::: "memory")
__device__ __forceinline__ float bf2f(unsigned b) { return __uint_as_float(b << 16); }
__device__ __forceinline__ unsigned f2bf(float f) { unsigned u = __float_as_uint(f); return (u + 0x7fffu + ((u >> 16) & 1u)) >> 16; }
typedef float f32x2_t __attribute__((ext_vector_type(2))); typedef __bf16 bf16x2_t __attribute__((ext_vector_type(2)));
__device__ __forceinline__ unsigned pk2(float lo, float hi) { const f32x2_t v = {lo, hi}; const bf16x2_t b = __builtin_convertvector(v, bf16x2_t); return __builtin_bit_cast(unsigned, b); }
__device__ __forceinline__ float ex2(float x) { return __builtin_amdgcn_exp2f(x); }
__device__ __forceinline__ float wave_sum(float v) {
#pragma unroll
    for (int o = 1; o < 64; o <<= 1) v += __shfl_xor(v, o);
    return v;
}

__constant__ unsigned char T5_BUCKET[3][132] = {
 {0,1,2,3,4,5,6,7,8,9,10,11,12,13,14,15,16,16,16,16,16,16,17,17,17,17,17,17,17,17,18,18,18,18,18,18,18,18,18,18,19,19,19,19,19,19,19,19,19,19,19,19,19,19,20,20,20,20,20,20,20,20,20,20,20,20,20,20,20,20,20,20,20,21,21,21,21,21,21,21,21,21,21,21,21,21,21,21,21,21,21,21,21,21,21,21,21,21,21,22,22,22,22,22,22,22,22,22,22,22,22,22,22,22,22,22,22,22,22,22,22,22,22,22,22,22,22,22,22,0,0,0},
 {0,4,8,12,16,16,17,17,18,18,19,19,19,19,20,20,20,20,20,21,21,21,21,21,21,22,22,22,22,22,22,22,22,22,23,23,23,23,23,23,23,23,23,23,23,23,24,24,24,24,24,24,24,24,24,24,24,24,24,24,24,24,25,25,25,25,25,25,25,25,25,25,25,25,25,25,25,25,25,25,25,25,25,26,26,26,26,26,26,26,26,26,26,26,26,26,26,26,26,26,26,26,26,26,26,26,26,26,26,26,26,26,26,27,27,27,27,27,27,27,27,27,27,27,27,27,27,27,27,0,0,0},
 {0,16,18,19,20,21,21,22,22,23,23,23,24,24,24,24,25,25,25,25,25,26,26,26,26,26,26,26,26,27,27,27,27,27,27,27,27,27,27,28,28,28,28,28,28,28,28,28,28,28,28,28,29,29,29,29,29,29,29,29,29,29,29,29,29,29,29,29,29,29,30,30,30,30,30,30,30,30,30,30,30,30,30,30,30,30,30,30,30,30,30,30,30,30,30,31,31,31,31,31,31,31,31,31,31,31,31,31,31,31,31,31,31,31,31,31,31,31,31,31,31,31,31,31,31,31,31,31,31,0,0,0}};

struct Params { const float* in[15]; float* out; unsigned char* ws; int ph_lo, ph_hi; };

__device__ __forceinline__ void transpose_item(const float* __restrict__ W, int K, int N, bf16* WT, int mode, float* scr, int item, int lane) {
    const int nblk = N / 32, kb = item / nblk, nb = item % nblk, k0 = 64 * kb, n0 = 32 * nb;
#pragma unroll 8
    for (int i = 0; i < 32; ++i) { const int kk = 2 * i + (lane >> 5); scr[kk * 33 + (lane & 31)] = __builtin_nontemporal_load(W + (size_t)(k0 + kk) * N + n0 + (lane & 31)); }
    LDS_WAIT();
    int drow0 = n0;
    if ((mode & 3) == 1) { const int isup = n0 >= DFF ? 1 : 0; const int j0 = n0 - isup * DFF; drow0 = (j0 >> 7) * 256 + isup * 128 + (j0 & 127); }
    if ((mode & 3) == 2) { const int kv = n0 >= 3072 ? 1 : 0; const int c = n0 - kv * 3072; drow0 = (c >> 10) * 2048 + kv * 1024 + (c & 1023); }
    const int c = lane & 7;
#pragma unroll
    for (int j = 0; j < 4; ++j) { const int n = (lane >> 3) + 8 * j; const float* s = scr + (8 * c) * 33 + n;
        v4u o; o.x = pk2(s[0 * 33], s[1 * 33]); o.y = pk2(s[2 * 33], s[3 * 33]); o.z = pk2(s[4 * 33], s[5 * 33]); o.w = pk2(s[6 * 33], s[7 * 33]);
        if (mode & 4) __builtin_nontemporal_store(o, (v4u*)(WT + (size_t)(drow0 + n) * K + k0 + 8 * c)); else *(v4u*)(WT + (size_t)(drow0 + n) * K + k0 + 8 * c) = o; }
    LDS_WAIT();
}
constexpr int IT_IN = 16 * 176, IT_OUT = 44 * 32, IT_AIN = 16 * 128, IT_SQ = 16 * 32, IT_KV = 16 * 192, IT_Q = 16 * 96;
__device__ __forceinline__ void convert_layer0(const Params& p, unsigned char* lds, int gw, int ngw, int wave, int lane) {
    float* scr = (float*)(lds + wave * 16384); unsigned char* ws = p.ws;
    constexpr int NIT = 2 * IT_IN + 2 * IT_OUT + IT_AIN + IT_SQ;
    for (int it = gw; it < NIT; it += ngw) { int r = it;
        if (r < IT_IN) { transpose_item(p.in[2], DM, 2 * DFF, (bf16*)(ws + WS_WIN0), 1, scr, r, lane); continue; } r -= IT_IN;
        if (r < IT_IN) { transpose_item(p.in[2] + (size_t)1 * DM * 2 * DFF, DM, 2 * DFF, (bf16*)(ws + WS_WIN1), 5, scr, r, lane); continue; } r -= IT_IN;
        if (r < IT_OUT) { transpose_item(p.in[3], DFF, DM, (bf16*)(ws + WS_WOUT0), 0, scr, r, lane); continue; } r -= IT_OUT;
        if (r < IT_OUT) { transpose_item(p.in[3] + (size_t)1 * DFF * DM, DFF, DM, (bf16*)(ws + WS_WOUT1), 4, scr, r, lane); continue; } r -= IT_OUT;
        if (r < IT_AIN) { transpose_item(p.in[4], DM, 4096, (bf16*)(ws + WS_WAIN), 4, scr, r, lane); continue; } r -= IT_AIN;
        transpose_item(p.in[7], DM, DM, (bf16*)(ws + WS_WAOUT), 4, scr, r, lane);
    }
}
__device__ __forceinline__ void convert_layer1(const Params& p, unsigned char* lds, int gw, int ngw, int wave, int lane) {
    float* scr = (float*)(lds + wave * 16384); unsigned char* ws = p.ws;
    constexpr int NIT = 2 * IT_IN + 2 * IT_OUT + IT_KV + IT_Q + IT_SQ;
    for (int it = gw; it < NIT; it += ngw) { int r = it;
        if (r < IT_IN) { transpose_item(p.in[2] + (size_t)2 * DM * 2 * DFF, DM, 2 * DFF, (bf16*)(ws + WS_WIN2), 5, scr, r, lane); continue; } r -= IT_IN;
        if (r < IT_IN) { transpose_item(p.in[2] + (size_t)3 * DM * 2 * DFF, DM, 2 * DFF, (bf16*)(ws + WS_WIN3), 5, scr, r, lane); continue; } r -= IT_IN;
        if (r < IT_OUT) { transpose_item(p.in[3] + (size_t)2 * DFF * DM, DFF, DM, (bf16*)(ws + WS_WOUT2), 4, scr, r, lane); continue; } r -= IT_OUT;
        if (r < IT_OUT) { transpose_item(p.in[3] + (size_t)3 * DFF * DM, DFF, DM, (bf16*)(ws + WS_WOUT3), 4, scr, r, lane); continue; } r -= IT_OUT;
        if (r < IT_KV) { transpose_item(p.in[9], DM, 6144, (bf16*)(ws + WS_WKV), 6, scr, r, lane); continue; } r -= IT_KV;
        if (r < IT_Q) { transpose_item(p.in[11], DM, 3072, (bf16*)(ws + WS_WQ), 4, scr, r, lane); continue; } r -= IT_Q;
        transpose_item(p.in[13], DM, DM, (bf16*)(ws + WS_WO), 4, scr, r, lane);
    }
}

__device__ __forceinline__ void rms_rows(const float* x, const float* g1, bf16* o1, const float* g2, bf16* o2, int gw, int ngw, int lane) {
    f32x4 ga[4], gb[4];
#pragma unroll
    for (int j = 0; j < 4; ++j) { ga[j] = ((const f32x4*)g1)[lane + 64 * j]; gb[j] = g2 ? ((const f32x4*)g2)[lane + 64 * j] : ga[j]; }
    for (int m = gw; m < MTOK; m += ngw) {
        const f32x4* xr = (const f32x4*)(x + (size_t)m * DM) + lane; f32x4 v[4]; float s = 0.f;
#pragma unroll
        for (int j = 0; j < 4; ++j) { v[j] = __builtin_nontemporal_load(xr + 64 * j); s += (v[j].x * v[j].x + v[j].y * v[j].y) + (v[j].z * v[j].z + v[j].w * v[j].w); }
        const float rstd = rsqrtf(wave_sum(s) * (1.0f / DM) + EPS);
        v2u* q1 = (v2u*)(o1 + (size_t)m * DM) + lane;
#pragma unroll
        for (int j = 0; j < 4; ++j) { const f32x4 y = v[j] * rstd; v2u w; w.x = pk2(y.x * ga[j].x, y.y * ga[j].y); w.y = pk2(y.z * ga[j].z, y.w * ga[j].w); q1[64 * j] = w; }
        if (g2) { v2u* q2 = (v2u*)(o2 + (size_t)m * DM) + lane;
#pragma unroll
            for (int j = 0; j < 4; ++j) { const f32x4 y = v[j] * rstd; v2u w; w.x = pk2(y.x * gb[j].x, y.y * gb[j].y); w.y = pk2(y.z * gb[j].z, y.w * gb[j].w); q2[64 * j] = w; } }
    }
}

constexpr int RS = 272, VS = 144;
constexpr int A_KH = 0, A_VT = A_KH + 128 * VS, A_TOT = A_VT + 128 * VS;
constexpr int C_QT = 0, C_QP = C_QT + 64 * RS, C_KT = C_QP + 64 * RS, C_VT = C_KT + 160 * RS, C_ST = C_VT + 128 * VS, C_TOT = C_ST + 128 * RS, C_PART = C_TOT + 4096, C_END = C_PART + 512;
static_assert(C_END <= LDS_BYTES, "pass C LDS map");
__device__ __forceinline__ void hgrn_stage_vt(unsigned char* Vt, const v4u we, const v4u wo, int tid) {
    const int tp = tid & 31, c8 = tid >> 5;
    unsigned char* vd = Vt + (8 * c8) * VS + 4 * tp;
    *(unsigned*)(vd + 0 * VS) = (we.x & 0xffffu) | (wo.x << 16); *(unsigned*)(vd + 1 * VS) = (we.x >> 16) | (wo.x & 0xffff0000u);
    *(unsigned*)(vd + 2 * VS) = (we.y & 0xffffu) | (wo.y << 16); *(unsigned*)(vd + 3 * VS) = (we.y >> 16) | (wo.y & 0xffff0000u);
    *(unsigned*)(vd + 4 * VS) = (we.z & 0xffffu) | (wo.z << 16); *(unsigned*)(vd + 5 * VS) = (we.z >> 16) | (wo.z & 0xffff0000u);
    *(unsigned*)(vd + 6 * VS) = (we.w & 0xffffu) | (wo.w << 16); *(unsigned*)(vd + 7 * VS) = (we.w >> 16) | (wo.w & 0xffff0000u);
}
__device__ __forceinline__ void hgrn_pass_a(const Params& p, unsigned char* lds) {
    int tid = threadIdx.x; asm volatile("" : "+v"(tid));
    const int lane = tid & 63, hs = __builtin_amdgcn_readfirstlane(tid >> 6), dp = lane, l15 = lane & 15, q4 = lane >> 4;
    unsigned char* ws = p.ws;
    unsigned char* Kh = lds + A_KH; unsigned char* Vt = lds + A_VT; float* tot = (float*)(lds + A_TOT);
    const float* LF = (const float*)(ws + WS_LF); const bf16* VH = (const bf16*)(ws + WS_VH); bf16* ST = (bf16*)(ws + WS_ST); float* DC = (float*)(ws + WS_DC);
    v2u rlf[8]; v4u rve, rvo;
#define HA_LOAD(U) do { const int bh_ = (U) / NCHUNK, c_ = (U) % NCHUNK; const size_t r0_ = (size_t)(bh_ >> 3) * SEQ + (size_t)c_ * 64; const int h_ = bh_ & 7; \
        _Pragma("unroll") for (int u = 0; u < 8; ++u) rlf[u] = *(const v2u*)(LF + (r0_ + 8 * hs + u) * DM + h_ * 128 + 2 * dp); \
        const size_t vo_ = (r0_ + 2 * (tid & 31)) * DM + h_ * 128 + (tid >> 5) * 8; rve = *(const v4u*)(VH + vo_); rvo = *(const v4u*)(VH + vo_ + DM); } while (0)
#define HG_UNIT(li) ((((li) & 15) * NCHUNK) + ((li) >> 4))
    if ((int)blockIdx.x < 16 * NCHUNK) HA_LOAD(HG_UNIT((int)blockIdx.x));
    for (int li = blockIdx.x; li < 16 * NCHUNK; li += gridDim.x) { const int unit = HG_UNIT(li);
        __syncthreads();
        hgrn_stage_vt(Vt, rve, rvo, tid);
        float c0[8], c1[8], k0[8], k1[8]; float run0 = 0.f, run1 = 0.f;
#pragma unroll
        for (int u = 0; u < 8; ++u) { const float x0 = __uint_as_float(rlf[u].x), x1 = __uint_as_float(rlf[u].y);
            k0[u] = 1.0f - ex2(x0); k1[u] = 1.0f - ex2(x1); run0 += x0; run1 += x1; c0[u] = run0; c1[u] = run1; }
        tot[hs * 128 + 2 * dp] = run0; tot[hs * 128 + 2 * dp + 1] = run1;
        if (li + (int)gridDim.x < 16 * NCHUNK) HA_LOAD(HG_UNIT(li + (int)gridDim.x));
        __syncthreads();
        float suf0 = 0.f, suf1 = 0.f;
#pragma unroll
        for (int hh = 1; hh < 8; ++hh) { const float t0 = tot[hh * 128 + 2 * dp], t1 = tot[hh * 128 + 2 * dp + 1]; if (hh > hs) { suf0 += t0; suf1 += t1; } }
        if (hs == 0) { DC[(size_t)unit * 128 + 2 * dp] = run0 + suf0; DC[(size_t)unit * 128 + 2 * dp + 1] = run1 + suf1; }
        { float a[8], bb[8];
#pragma unroll
          for (int u = 0; u < 8; ++u) { a[u] = k0[u] * ex2(suf0 + run0 - c0[u]); bb[u] = k1[u] * ex2(suf1 + run1 - c1[u]); }
          v4u o; o.x = pk2(a[0], a[1]); o.y = pk2(a[2], a[3]); o.z = pk2(a[4], a[5]); o.w = pk2(a[6], a[7]); *(v4u*)(Kh + (2 * dp) * VS + 16 * hs) = o;
          o.x = pk2(bb[0], bb[1]); o.y = pk2(bb[2], bb[3]); o.z = pk2(bb[4], bb[5]); o.w = pk2(bb[6], bb[7]); *(v4u*)(Kh + (2 * dp + 1) * VS + 16 * hs) = o; }
        __syncthreads();
        pg8::f32x4 acc[8];
#pragma unroll
        for (int ne = 0; ne < 8; ++ne) acc[ne] = (pg8::f32x4){0.f, 0.f, 0.f, 0.f};
#pragma unroll
        for (int ks = 0; ks < 2; ++ks) { const pg8::bf16x8 a = *(const pg8::bf16x8*)(Kh + (16 * hs + l15) * VS + 64 * ks + 16 * q4);
#pragma unroll
            for (int ne = 0; ne < 8; ++ne) { const pg8::bf16x8 bfr = *(const pg8::bf16x8*)(Vt + (16 * ne + l15) * VS + 64 * ks + 16 * q4);
                acc[ne] = __builtin_amdgcn_mfma_f32_16x16x32_bf16(a, bfr, acc[ne], 0, 0, 0); } }
#pragma unroll
        for (int ne = 0; ne < 8; ++ne) { v2u wv; wv.x = pk2(acc[ne][0], acc[ne][1]); wv.y = pk2(acc[ne][2], acc[ne][3]);
            *(v2u*)(ST + ((size_t)unit * 128 + 16 * ne + l15) * 128 + 16 * hs + 4 * q4) = wv; }
    }
#undef HA_LOAD
}
__device__ __forceinline__ void hgrn_pass_b(const Params& p, bool dry) {
    int tid = threadIdx.x; asm volatile("" : "+v"(tid));
    unsigned* ST = (unsigned*)(p.ws + WS_ST); const float* DC = (const float*)(p.ws + WS_DC);
    for (int gid = blockIdx.x * 512 + tid; gid < 16 * 128 * 64; gid += gridDim.x * 512) {
        const int bh = gid >> 13, rem = gid & 8191, d2 = rem & 63;
        unsigned* sp = ST + (size_t)bh * NCHUNK * 8192 + rem; const float* dp = DC + (size_t)bh * NCHUNK * 128 + 2 * d2;
        float s0 = 0.f, s1 = 0.f;
        for (int c0 = 0; c0 < NCHUNK; c0 += 8) { unsigned w[8]; v2u dc[8];
#pragma unroll
            for (int j = 0; j < 8; ++j) { w[j] = __builtin_nontemporal_load(sp + (size_t)(c0 + j) * 8192); dc[j] = *(const v2u*)(dp + (c0 + j) * 128); }
#pragma unroll
            for (int j = 0; j < 8; ++j) { if (!dry || s0 == 1.2345e30f) sp[(size_t)(c0 + j) * 8192] = pk2(s0, s1); s0 = ex2(__uint_as_float(dc[j].x)) * s0 + bf2f(w[j] & 0xffffu); s1 = ex2(__uint_as_float(dc[j].y)) * s1 + bf2f(w[j] >> 16); } }
    }
}
__device__ __forceinline__ void hgrn_pass_c(const Params& p, unsigned char* lds, bool dry) {
    int tid = threadIdx.x; asm volatile("" : "+v"(tid));
    const int lane = tid & 63, hs = __builtin_amdgcn_readfirstlane(tid >> 6), dp = lane, l15 = lane & 15, q4 = lane >> 4;
    unsigned char* ws = p.ws;
    unsigned char* Qt = lds + C_QT; unsigned char* Qp = lds + C_QP; unsigned char* Kt = lds + C_KT; unsigned char* Vt = lds + C_VT; unsigned char* St = lds + C_ST;
    float* tot = (float*)(lds + C_TOT); float* part = (float*)(lds + C_PART);
    const float* LF = (const float*)(ws + WS_LF); const bf16* VH = (const bf16*)(ws + WS_VH); const bf16* QH = (const bf16*)(ws + WS_QH); const bf16* GH = (const bf16*)(ws + WS_GH);
    const bf16* ST = (const bf16*)(ws + WS_ST); bf16* OG = (bf16*)(ws + WS_QH); const float* ogain = p.in[6];
    const int ti = hs & 3, eh = hs >> 2;
    f32x4 gnv[4];
#pragma unroll
    for (int me = 0; me < 4; ++me) gnv[me] = *(const f32x4*)(ogain + 64 * eh + 16 * me + 4 * q4);
    v2u rlf[8]; unsigned rq[8]; v4u rve, rvo, rst[4]; v2u rgh[4];
#define HC_LOAD(U) do { const int bh_ = (U) / NCHUNK, c_ = (U) % NCHUNK; const size_t r0_ = (size_t)(bh_ >> 3) * SEQ + (size_t)c_ * 64; const int h_ = bh_ & 7; \
        _Pragma("unroll") for (int u = 0; u < 8; ++u) { const size_t go_ = (r0_ + 8 * hs + u) * DM + h_ * 128 + 2 * dp; rlf[u] = *(const v2u*)(LF + go_); rq[u] = __builtin_nontemporal_load((const unsigned*)(QH + go_)); } \
        const size_t vo_ = (r0_ + 2 * (tid & 31)) * DM + h_ * 128 + (tid >> 5) * 8; rve = *(const v4u*)(VH + vo_); rvo = *(const v4u*)(VH + vo_ + DM); \
        _Pragma("unroll") for (int it = 0; it < 4; ++it) { const int idx_ = tid + 512 * it; rst[it] = __builtin_nontemporal_load((const v4u*)(ST + ((size_t)(U) * 128 + (idx_ >> 4)) * 128 + (idx_ & 15) * 8)); } \
        _Pragma("unroll") for (int me = 0; me < 4; ++me) rgh[me] = __builtin_nontemporal_load((const v2u*)(GH + (r0_ + 16 * ti + l15) * DM + h_ * 128 + 64 * eh + 16 * me + 4 * q4)); } while (0)
    if ((int)blockIdx.x < 16 * NCHUNK) HC_LOAD(HG_UNIT((int)blockIdx.x));
    for (int li = blockIdx.x; li < 16 * NCHUNK; li += gridDim.x) { const int unit = HG_UNIT(li);
        const int bh = unit / NCHUNK, c = unit % NCHUNK, b = bh >> 3, h = bh & 7; const size_t row0 = (size_t)b * SEQ + (size_t)c * 64;
        __syncthreads();
        hgrn_stage_vt(Vt, rve, rvo, tid);
#pragma unroll
        for (int it = 0; it < 4; ++it) { const int idx = tid + 512 * it, e = idx >> 4, c16 = idx & 15; *(v4u*)(St + e * RS + c16 * 16) = rst[it]; }
        float c0[8], c1[8], k0[8], k1[8], qa[8], qb[8]; float run0 = 0.f, run1 = 0.f;
#pragma unroll
        for (int u = 0; u < 8; ++u) { const float x0 = __uint_as_float(rlf[u].x), x1 = __uint_as_float(rlf[u].y);
            qa[u] = bf2f(rq[u] & 0xffffu); qb[u] = bf2f(rq[u] >> 16);
            k0[u] = 1.0f - ex2(x0); k1[u] = 1.0f - ex2(x1); run0 += x0; run1 += x1; c0[u] = run0; c1[u] = run1; }
        v2u gh[4];
#pragma unroll
        for (int me = 0; me < 4; ++me) gh[me] = rgh[me];
        tot[hs * 128 + 2 * dp] = run0; tot[hs * 128 + 2 * dp + 1] = run1;
        if (li + (int)gridDim.x < 16 * NCHUNK) HC_LOAD(HG_UNIT(li + (int)gridDim.x));
        __syncthreads();
        {
          float base0 = 0.f, base1 = 0.f, R0[4], R1[4]; float p0 = 0.f, p1 = 0.f;
#pragma unroll
          for (int hh = 0; hh < 8; ++hh) { if ((hh & 1) == 0) { R0[hh >> 1] = p0; R1[hh >> 1] = p1; } if (hh == hs) { base0 = p0; base1 = p1; }
              p0 += tot[hh * 128 + 2 * dp]; p1 += tot[hh * 128 + 2 * dp + 1]; }
          const int i = hs >> 1;
          const float Ri0 = i == 0 ? R0[0] : (i == 1 ? R0[1] : (i == 2 ? R0[2] : R0[3])), Ri1 = i == 0 ? R1[0] : (i == 1 ? R1[1] : (i == 2 ? R1[2] : R1[3]));
#pragma unroll
          for (int u = 0; u < 8; ++u) { const int t = 8 * hs + u; const float cu0 = base0 + c0[u], cu1 = base1 + c1[u];
              *(unsigned*)(Qp + t * RS + 4 * dp) = pk2(qa[u] * ex2(cu0), qb[u] * ex2(cu1));
              *(unsigned*)(Qt + t * RS + 4 * dp) = pk2(qa[u] * ex2(cu0 - Ri0), qb[u] * ex2(cu1 - Ri1));
#pragma unroll
              for (int ip = 0; ip < 4; ++ip) if (ip >= i) *(unsigned*)(Kt + (8 * ip * (ip + 1) + t) * RS + 4 * dp) = pk2(k0[u] * ex2(R0[ip] - cu0), k1[u] * ex2(R1[ip] - cu1)); } }
        __syncthreads();
        pg8::f32x4 sct[4]; pg8::bf16x8 qf[4];
#pragma unroll
        for (int ks = 0; ks < 4; ++ks) qf[ks] = *(const pg8::bf16x8*)(Qt + (16 * ti + l15) * RS + 64 * ks + 16 * q4);
#pragma unroll
        for (int j = 0; j < 4; ++j) { sct[j] = (pg8::f32x4){0.f, 0.f, 0.f, 0.f};
            if (j <= ti) { const unsigned char* kr = Kt + (8 * ti * (ti + 1) + 16 * j + l15) * RS + 16 * q4;
#pragma unroll
                for (int ks = 0; ks < 4; ++ks) sct[j] = __builtin_amdgcn_mfma_f32_16x16x32_bf16(*(const pg8::bf16x8*)(kr + 64 * ks), qf[ks], sct[j], 0, 0, 0);
                if (j == ti) {
#pragma unroll
                    for (int r = 0; r < 4; ++r) if (4 * q4 + r > l15) sct[j][r] = 0.f; } } }
        pg8::f32x4 o[4];
#pragma unroll
        for (int me = 0; me < 4; ++me) o[me] = (pg8::f32x4){0.f, 0.f, 0.f, 0.f};
#pragma unroll
        for (int pp = 0; pp < 2; ++pp) if (2 * pp <= ti) {
            v4u pw; pw.x = pk2(sct[2 * pp][0], sct[2 * pp][1]); pw.y = pk2(sct[2 * pp][2], sct[2 * pp][3]); pw.z = pk2(sct[2 * pp + 1][0], sct[2 * pp + 1][1]); pw.w = pk2(sct[2 * pp + 1][2], sct[2 * pp + 1][3]);
            const pg8::bf16x8 bfr = __builtin_bit_cast(pg8::bf16x8, pw);
#pragma unroll
            for (int me = 0; me < 4; ++me) { const unsigned char* vr = Vt + (64 * eh + 16 * me + l15) * VS + (32 * pp + 4 * q4) * 2;
                const v2u lo = *(const v2u*)vr, hi = *(const v2u*)(vr + 32); v4u aw; aw.x = lo.x; aw.y = lo.y; aw.z = hi.x; aw.w = hi.y;
                o[me] = __builtin_amdgcn_mfma_f32_16x16x32_bf16(__builtin_bit_cast(pg8::bf16x8, aw), bfr, o[me], 0, 0, 0); } }
#pragma unroll
        for (int ks = 0; ks < 4; ++ks) { const pg8::bf16x8 bq = *(const pg8::bf16x8*)(Qp + (16 * ti + l15) * RS + 64 * ks + 16 * q4);
#pragma unroll
            for (int me = 0; me < 4; ++me) o[me] = __builtin_amdgcn_mfma_f32_16x16x32_bf16(*(const pg8::bf16x8*)(St + (64 * eh + 16 * me + l15) * RS + 64 * ks + 16 * q4), bq, o[me], 0, 0, 0); }
        float ss = 0.f;
#pragma unroll
        for (int me = 0; me < 4; ++me) ss += (o[me][0] * o[me][0] + o[me][1] * o[me][1]) + (o[me][2] * o[me][2] + o[me][3] * o[me][3]);
        ss += __shfl_xor(ss, 16); ss += __shfl_xor(ss, 32);
        if (q4 == 0) part[hs * 16 + l15] = ss;
        __syncthreads();
        ss += part[(hs ^ 4) * 16 + l15];
        const float rstd = rsqrtf(ss * (1.0f / 128.0f) + EPS);
#pragma unroll
        for (int me = 0; me < 4; ++me) { const int e0 = 64 * eh + 16 * me + 4 * q4; const size_t off = (row0 + 16 * ti + l15) * DM + h * 128 + e0;
            const f32x4 gn = gnv[me]; const v2u gw = gh[me];
            v2u wv; wv.x = pk2(o[me][0] * rstd * gn.x * bf2f(gw.x & 0xffffu), o[me][1] * rstd * gn.y * bf2f(gw.x >> 16));
            wv.y = pk2(o[me][2] * rstd * gn.z * bf2f(gw.y & 0xffffu), o[me][3] * rstd * gn.w * bf2f(gw.y >> 16));
            if (!dry || ss < 0.f) *(v2u*)(OG + off) = wv; }
    }
#undef HC_LOAD
}

constexpr int KB_STRIDE = 144, VT_STRIDE = 528, ATT_VT_OFF = 256 * KB_STRIDE, ATT_BIAS_OFF = ATT_VT_OFF + 64 * VT_STRIDE;
__device__ __forceinline__ void unpack8(const v4u w, float* f) {
    f[0] = bf2f(w.x & 0xffffu); f[1] = bf2f(w.x >> 16); f[2] = bf2f(w.y & 0xffffu); f[3] = bf2f(w.y >> 16);
    f[4] = bf2f(w.z & 0xffffu); f[5] = bf2f(w.z >> 16); f[6] = bf2f(w.w & 0xffffu); f[7] = bf2f(w.w >> 16);
}
struct AttnRaw { v4u kw[4]; v4u ve[2], vo[2]; v4u qa, qb; v2u oo[4]; float lold; float bias; };
__device__ __forceinline__ void attn_unit_coords(int unit, int nqb, int dl, int& b, int& h, int& r, int& i0) {
    const int bh = unit >> 7, xq = unit & 127; b = bh >> 4; h = bh & 15; r = xq / nqb; i0 = (xq % nqb) * 128;
}
__device__ __forceinline__ void attn_load(AttnRaw& R, int unit, int g, int dl, int nqb, const bf16* QG, const bf16* KG, const bf16* VG, const bf16* OACC, const float* LSE, const float* relb_g, int tid, int w, int l15, int q4) {
    int b, h, r, i0; attn_unit_coords(unit, nqb, dl, b, h, r, i0); const size_t rowb = (size_t)b * SEQ;
    const size_t hb = ((size_t)(b * 16 + h) << 14) + (size_t)r * (SEQ / dl);
#pragma unroll
    for (int it = 0; it < 4; ++it) { const int idx = tid + 512 * it, jl = idx >> 3, c8 = idx & 7; const int jj = i0 - 128 + jl;
        R.kw[it] = (v4u){0u, 0u, 0u, 0u};
        if (jj >= 0) R.kw[it] = *(const v4u*)(KG + (hb + jj) * 64 + c8 * 8); }
#pragma unroll
    for (int it = 0; it < 2; ++it) { const int idx = tid + 512 * it, kp = idx & 127, c8 = idx >> 7; const int jj = i0 - 128 + 2 * kp;
        R.ve[it] = (v4u){0u, 0u, 0u, 0u}; R.vo[it] = (v4u){0u, 0u, 0u, 0u};
        if (jj >= 0) { const size_t off = (hb + jj) * 64 + c8 * 8; R.ve[it] = *(const v4u*)(VG + off); R.vo[it] = *(const v4u*)(VG + off + 64); } }
    const size_t qrow = rowb + r + (size_t)dl * (i0 + 16 * w + l15);
    const size_t qoff = (hb + i0 + 16 * w + l15) * 64;
    R.qa = __builtin_nontemporal_load((const v4u*)(QG + qoff + 8 * q4)); R.qb = __builtin_nontemporal_load((const v4u*)(QG + qoff + 32 + 8 * q4));
    R.lold = 0.f; R.bias = tid < 129 ? relb_g[h] : 0.f;
#pragma unroll
    for (int md = 0; md < 4; ++md) R.oo[md] = (v2u){0u, 0u};
    if (g > 0) { R.lold = LSE[qrow * 16 + h];
#pragma unroll
        for (int md = 0; md < 4; ++md) R.oo[md] = __builtin_nontemporal_load((const v2u*)(OACC + qrow * DM + h * 64 + 4 * q4 + 16 * md)); }
}
__device__ __forceinline__ void attn_group(const Params& p, unsigned char* lds, int g) {
    int tid = threadIdx.x; asm volatile("" : "+v"(tid));
    const int lane = tid & 63, w = __builtin_amdgcn_readfirstlane(tid >> 6), l15 = lane & 15, q4 = lane >> 4;
    unsigned char* ws = p.ws;
    unsigned char* Kb = lds; unsigned char* Vt = lds + ATT_VT_OFF; float* bias = (float*)(lds + ATT_BIAS_OFF);
    const bf16* QG = (const bf16*)(ws + WS_QG); const bf16* KG = (const bf16*)(ws + WS_KG); const bf16* VG = (const bf16*)(ws + WS_VG);
    bf16* OACC = (bf16*)(ws + WS_QH); float* LSE = (float*)(ws + WS_LSE);
    const float* kgain = p.in[10] + g * 64; const float* qgain = p.in[12] + g * 64; const float* relb = p.in[14];
    const int dl = g == 0 ? 1 : (g == 1 ? 4 : 16), nqb = 128 / dl;
    const int G = gridDim.x, bx = blockIdx.x; const int vcu = (G % 8 == 0) ? (bx % 8) * (G / 8) + bx / 8 : bx;
    const float* relb_g = relb + (int)T5_BUCKET[g][tid < 129 ? tid : 0] * 48 + g * 16;
    const int c8k = tid & 7;
    const f32x4 kg0 = *(const f32x4*)(kgain + c8k * 8), kg1 = *(const f32x4*)(kgain + c8k * 8 + 4);
    const f32x4 ga0 = *(const f32x4*)(qgain + 8 * q4), ga1 = *(const f32x4*)(qgain + 8 * q4 + 4), gb0 = *(const f32x4*)(qgain + 32 + 8 * q4), gb1 = *(const f32x4*)(qgain + 32 + 8 * q4 + 4);
    AttnRaw R;
    if (vcu < 2 * 16 * 128) attn_load(R, vcu, g, dl, nqb, QG, KG, VG, OACC, LSE, relb_g, tid, w, l15, q4);
    for (int unit = vcu; unit < 2 * 16 * 128; unit += G) {
        int b, h, r, i0; attn_unit_coords(unit, nqb, dl, b, h, r, i0);
        const size_t rowb = (size_t)b * SEQ;
        __syncthreads();
        if (tid < 129) bias[tid] = R.bias * LOG2E;
#pragma unroll
        for (int it = 0; it < 4; ++it) { const int idx = tid + 512 * it, jl = idx >> 3, c8 = idx & 7;
            float kf[8]; unpack8(R.kw[it], kf);
            float ss = 0.f;
#pragma unroll
            for (int e = 0; e < 8; ++e) ss += kf[e] * kf[e];
            ss += __shfl_xor(ss, 1); ss += __shfl_xor(ss, 2); ss += __shfl_xor(ss, 4);
            const float rstd = rsqrtf(ss * (1.0f / 64.0f) + EPS);
            v4u o; o.x = pk2(kf[0] * rstd * kg0.x, kf[1] * rstd * kg0.y); o.y = pk2(kf[2] * rstd * kg0.z, kf[3] * rstd * kg0.w);
            o.z = pk2(kf[4] * rstd * kg1.x, kf[5] * rstd * kg1.y); o.w = pk2(kf[6] * rstd * kg1.z, kf[7] * rstd * kg1.w);
            *(v4u*)(Kb + jl * KB_STRIDE + c8 * 16) = o; }
#pragma unroll
        for (int it = 0; it < 2; ++it) { const int idx = tid + 512 * it, kp = idx & 127, c8 = idx >> 7; const v4u we = R.ve[it], wo = R.vo[it];
            unsigned char* vd = Vt + (8 * c8) * VT_STRIDE + 4 * kp;
            *(unsigned*)(vd + 0 * VT_STRIDE) = (we.x & 0xffffu) | (wo.x << 16); *(unsigned*)(vd + 1 * VT_STRIDE) = (we.x >> 16) | (wo.x & 0xffff0000u);
            *(unsigned*)(vd + 2 * VT_STRIDE) = (we.y & 0xffffu) | (wo.y << 16); *(unsigned*)(vd + 3 * VT_STRIDE) = (we.y >> 16) | (wo.y & 0xffff0000u);
            *(unsigned*)(vd + 4 * VT_STRIDE) = (we.z & 0xffffu) | (wo.z << 16); *(unsigned*)(vd + 5 * VT_STRIDE) = (we.z >> 16) | (wo.z & 0xffff0000u);
            *(unsigned*)(vd + 6 * VT_STRIDE) = (we.w & 0xffffu) | (wo.w << 16); *(unsigned*)(vd + 7 * VT_STRIDE) = (we.w >> 16) | (wo.w & 0xffff0000u); }
        const size_t qrow = rowb + r + (size_t)dl * (i0 + 16 * w + l15);
        pg8::bf16x8 qf0, qf1;
        { float qa[8], qb_[8]; unpack8(R.qa, qa); unpack8(R.qb, qb_);
          float ss = 0.f;
#pragma unroll
          for (int e = 0; e < 8; ++e) ss += qa[e] * qa[e] + qb_[e] * qb_[e];
          ss += __shfl_xor(ss, 16); ss += __shfl_xor(ss, 32);
          const float rstd = rsqrtf(ss * (1.0f / 64.0f) + EPS) * 0.125f * LOG2E;
          v4u o; o.x = pk2(qa[0] * rstd * ga0.x, qa[1] * rstd * ga0.y); o.y = pk2(qa[2] * rstd * ga0.z, qa[3] * rstd * ga0.w); o.z = pk2(qa[4] * rstd * ga1.x, qa[5] * rstd * ga1.y); o.w = pk2(qa[6] * rstd * ga1.z, qa[7] * rstd * ga1.w);
          qf0 = __builtin_bit_cast(pg8::bf16x8, o);
          o.x = pk2(qb_[0] * rstd * gb0.x, qb_[1] * rstd * gb0.y); o.y = pk2(qb_[2] * rstd * gb0.z, qb_[3] * rstd * gb0.w); o.z = pk2(qb_[4] * rstd * gb1.x, qb_[5] * rstd * gb1.y); o.w = pk2(qb_[6] * rstd * gb1.z, qb_[7] * rstd * gb1.w);
          qf1 = __builtin_bit_cast(pg8::bf16x8, o); }
        v2u oo[4]; const float lold = R.lold;
#pragma unroll
        for (int md = 0; md < 4; ++md) oo[md] = R.oo[md];
        if (unit + G < 2 * 16 * 128) attn_load(R, unit + G, g, dl, nqb, QG, KG, VG, OACC, LSE, relb_g, tid, w, l15, q4);
        __syncthreads();
        pg8::f32x4 s[9];
#pragma unroll
        for (int kt = 0; kt < 9; ++kt) { const unsigned char* kr = Kb + (16 * (w + kt) + l15) * KB_STRIDE + 16 * q4;
            const pg8::bf16x8 a0 = *(const pg8::bf16x8*)kr, a1 = *(const pg8::bf16x8*)(kr + 64);
            pg8::f32x4 z = (pg8::f32x4){0.f, 0.f, 0.f, 0.f};
            z = __builtin_amdgcn_mfma_f32_16x16x32_bf16(a0, qf0, z, 0, 0, 0);
            s[kt] = __builtin_amdgcn_mfma_f32_16x16x32_bf16(a1, qf1, z, 0, 0, 0); }
        float m = -INFINITY;
        if (i0 == 0) {
#pragma unroll
            for (int kt = 0; kt < 9; ++kt)
#pragma unroll
                for (int rr = 0; rr < 4; ++rr) { const int dlt = 128 - 16 * kt - 4 * q4 - rr + l15; const int jl = 16 * (w + kt) + 4 * q4 + rr;
                    const bool valid = dlt >= 0 && dlt <= 128 && jl >= 128;
                    const int dc = dlt < 0 ? 0 : (dlt > 128 ? 128 : dlt);
                    const float v = valid ? s[kt][rr] + bias[dc] : -INFINITY; s[kt][rr] = v; m = fmaxf(m, v); }
        } else {
            const int d0 = 128 - 4 * q4 + l15;
#pragma unroll
            for (int rr = 0; rr < 4; ++rr) { const int dlt = d0 - rr; const float v = dlt <= 128 ? s[0][rr] + bias[dlt > 128 ? 128 : dlt] : -INFINITY; s[0][rr] = v; m = fmaxf(m, v); }
#pragma unroll
            for (int kt = 1; kt < 8; ++kt)
#pragma unroll
                for (int rr = 0; rr < 4; ++rr) { const float v = s[kt][rr] + bias[d0 - 16 * kt - rr]; s[kt][rr] = v; m = fmaxf(m, v); }
#pragma unroll
            for (int rr = 0; rr < 4; ++rr) { const int dlt = d0 - 128 - rr; const float v = dlt >= 0 ? s[8][rr] + bias[dlt < 0 ? 0 : dlt] : -INFINITY; s[8][rr] = v; m = fmaxf(m, v); }
        }
        m = fmaxf(m, __shfl_xor(m, 16)); m = fmaxf(m, __shfl_xor(m, 32));
        float l = 0.f;
#pragma unroll
        for (int kt = 0; kt < 9; ++kt)
#pragma unroll
            for (int rr = 0; rr < 4; ++rr) { const float pr = ex2(s[kt][rr] - m); s[kt][rr] = pr; l += pr; }
        l += __shfl_xor(l, 16); l += __shfl_xor(l, 32);
        pg8::f32x4 o[4];
#pragma unroll
        for (int md = 0; md < 4; ++md) o[md] = (pg8::f32x4){0.f, 0.f, 0.f, 0.f};
#pragma unroll
        for (int pi = 0; pi < 5; ++pi) {
            v4u pw; pw.x = pk2(s[2 * pi][0], s[2 * pi][1]); pw.y = pk2(s[2 * pi][2], s[2 * pi][3]);
            if (pi < 4) { pw.z = pk2(s[2 * pi + 1][0], s[2 * pi + 1][1]); pw.w = pk2(s[2 * pi + 1][2], s[2 * pi + 1][3]); } else { pw.z = 0u; pw.w = 0u; }
            const pg8::bf16x8 bfr = __builtin_bit_cast(pg8::bf16x8, pw);
#pragma unroll
            for (int md = 0; md < 4; ++md) { const unsigned char* vr = Vt + (16 * md + l15) * VT_STRIDE + (16 * (w + 2 * pi) + 4 * q4) * 2;
                const v2u lo = *(const v2u*)vr; v2u hi = (v2u){0u, 0u}; if (pi < 4) hi = *(const v2u*)(vr + 32);
                v4u aw; aw.x = lo.x; aw.y = lo.y; aw.z = hi.x; aw.w = hi.y;
                o[md] = __builtin_amdgcn_mfma_f32_16x16x32_bf16(__builtin_bit_cast(pg8::bf16x8, aw), bfr, o[md], 0, 0, 0); } }
        const float inv = 1.0f / l; float lse2 = m + __log2f(l);
        bf16* op = OACC + qrow * DM + h * 64 + 4 * q4; float* lp = LSE + qrow * 16 + h;
        float a = 0.f, bq = inv;
        if (g > 0) { const float mx = fmaxf(lold, lse2); const float wo_ = ex2(lold - mx), wn = ex2(lse2 - mx); const float den = wo_ + wn; a = wo_ / den; bq = inv * wn / den; lse2 = mx + __log2f(den); }
#pragma unroll
        for (int md = 0; md < 4; ++md) { float v0 = o[md][0] * bq, v1 = o[md][1] * bq, v2 = o[md][2] * bq, v3 = o[md][3] * bq;
            if (g > 0) { const v2u ow = oo[md]; v0 += a * bf2f(ow.x & 0xffffu); v1 += a * bf2f(ow.x >> 16); v2 += a * bf2f(ow.y & 0xffffu); v3 += a * bf2f(ow.y >> 16); }
            v2u wv; wv.x = pk2(v0, v1); wv.y = pk2(v2, v3);
            if (g < 2) __builtin_nontemporal_store(wv, (v2u*)(op + 16 * md)); else *(v2u*)(op + 16 * md) = wv; }
        if (q4 == 0 && g < 2) *lp = lse2;
    }
}

#define XB_TMO      128
#define XB_XCNT(j)  (256  + 64 * (j))
#define XB_XSUB(j)  (1280 + 64 * (j))
#define XB_XGEN(j)  (2304 + 64 * (j))
#define XB_TOP      3328
#define XB_TOPGEN   3392
#define XCD_BAR_WORDS 3456
#define XB_SPIN_CAP (1u << 18)

__device__ __forceinline__ unsigned xb_ld(unsigned* p)              { return __hip_atomic_load(p, __ATOMIC_RELAXED, __HIP_MEMORY_SCOPE_AGENT); }
__device__ __forceinline__ unsigned xb_add(unsigned* p, unsigned v) { return __hip_atomic_fetch_add(p, v, __ATOMIC_RELAXED, __HIP_MEMORY_SCOPE_AGENT); }
__device__ __forceinline__ unsigned xb_xcc_id() { return (unsigned)__builtin_amdgcn_s_getreg((3 << 11) | 20) & 0xFu; }
#define XB_SPIN(cond, bar) do { unsigned _sp = 0; while (cond) { __builtin_amdgcn_s_sleep(1); \
    if ((++_sp & 255u) == 0u) { if (xb_ld(&(bar)[XB_TMO])) break; if (_sp > XB_SPIN_CAP) { atomicAdd(&(bar)[XB_TMO], 1u); break; } } } } while (0)

struct XcdBarrier {
    unsigned* bar; unsigned x;
    volatile LAS unsigned* st;
};

__device__ __forceinline__ XcdBarrier xcd_barrier_post(unsigned* bar, volatile LAS unsigned* st) {
    XcdBarrier b; b.bar = bar; b.x = xb_xcc_id(); b.st = st;
    if (threadIdx.x == 0) (void)xb_add(&bar[XB_XCNT(b.x)], 1u);
    return b;
}
__device__ __forceinline__ void xcd_barrier_complete(unsigned* bar, unsigned x, unsigned& nloc, unsigned& nx) {
    const unsigned G = gridDim.x * gridDim.y * gridDim.z;
    unsigned sum, cnt, mine, sp = 0u;
    for (;;) {
        sum = 0u; cnt = 0u; mine = 0u;
#pragma unroll
        for (unsigned j = 0; j < 16; ++j) { const unsigned c = xb_ld(&bar[XB_XCNT(j)]); sum += c; cnt += (c > 0u) ? 1u : 0u; mine = (j == x) ? c : mine; }
        if (sum == G) break;
        __builtin_amdgcn_s_sleep(1);
        if ((++sp & 255u) == 0u) { if (xb_ld(&bar[XB_TMO])) break; if (sp > XB_SPIN_CAP) { atomicAdd(&bar[XB_TMO], 1u); break; } }
    }
    nloc = mine > 0u ? mine : 1u; nx = cnt > 0u ? cnt : 1u;
}

__device__ __forceinline__ void xcd_barrier(const XcdBarrier& b) {
    asm volatile("s_waitcnt vmcnt(0)" ::: "memory");
    __syncthreads();
    if (threadIdx.x == 0) {
        unsigned* bar = b.bar;
        __builtin_amdgcn_s_waitcnt(0);
        unsigned nloc = b.st[0], nx = b.st[1];
        if (nloc == 0u) { xcd_barrier_complete(bar, b.x, nloc, nx); b.st[0] = nloc; b.st[1] = nx; }
        const unsigned old = xb_add(&bar[XB_XSUB(b.x)], 1u);
        const unsigned gen = old / nloc;
        if (old + 1u == (gen + 1u) * nloc) {
            __builtin_amdgcn_fence(__ATOMIC_RELEASE, "agent");
            asm volatile("s_waitcnt vmcnt(0)" ::: "memory");
            const unsigned og = xb_add(&bar[XB_TOP], 1u);
            const unsigned tg = og / nx;
            if (og + 1u == (tg + 1u) * nx) xb_add(&bar[XB_TOPGEN], 1u);
            else XB_SPIN(xb_ld(&bar[XB_TOPGEN]) == tg, bar);
            __builtin_amdgcn_fence(__ATOMIC_ACQUIRE, "agent");
            xb_add(&bar[XB_XGEN(b.x)], 1u);
            asm volatile("s_waitcnt vmcnt(0)" ::: "memory");
        } else {
            XB_SPIN(xb_ld(&bar[XB_XGEN(b.x)]) == gen, bar);
            __builtin_amdgcn_fence(__ATOMIC_ACQUIRE, "agent");
            asm volatile("s_waitcnt vmcnt(0)" ::: "memory");
        }
    }
    __syncthreads();
}

struct GridBarFn { static __device__ __forceinline__ void sync(unsigned* w, unsigned st) { XcdBarrier xb; xb.bar = w; xb.x = xb_xcc_id(); xb.st = (volatile LAS unsigned*)(size_t)st; xcd_barrier(xb); } };
template <class Epi> __device__ __forceinline__ void run_gemm(unsigned char* lds, const bf16* A, const bf16* Bt, int N, int K, const Epi& E) {
    pg8::Gemm g{A, Bt, MTOK, N, K}; pg8::StaticOrder S; S.init(MTOK, N, (int)gridDim.x, (int)blockIdx.x);
    pg8::gemm_phase<Epi, pg8::StaticOrder, true, true>((LAS unsigned char*)lds, g, S, E);
}
enum { T_CONV0 = 0, T_FFN_IN, T_RESID, T_RMS, T_AIN, T_HA, T_HB, T_HC, T_QKV, T_ATT };
constexpr int NPH = 21;
__device__ __forceinline__ void phase_desc(int ph, int& type, int& arg) {
    switch (ph) {
        case 0: type = T_CONV0; arg = 0; break;
        case 1: type = T_FFN_IN; arg = 0; break;   case 2: type = T_RESID; arg = 0; break;
        case 3: type = T_AIN; arg = 0; break;      case 4: type = T_HA; arg = 0; break;   case 5: type = T_HB; arg = 0; break;   case 6: type = T_HC; arg = 0; break;
        case 7: type = T_RESID; arg = 4; break;
        case 8: type = T_FFN_IN; arg = 1; break;   case 9: type = T_RESID; arg = 1; break;
        case 10: type = T_FFN_IN; arg = 2; break;  case 11: type = T_RESID; arg = 2; break;
        case 12: type = T_QKV; arg = 0; break;     case 13: type = T_ATT; arg = 0; break;
        case 14: type = T_QKV; arg = 1; break;     case 15: type = T_ATT; arg = 1; break;
        case 16: type = T_QKV; arg = 2; break;     case 17: type = T_ATT; arg = 2; break;
        case 18: type = T_RESID; arg = 5; break;
        case 19: type = T_FFN_IN; arg = 3; break;  default: type = T_RESID; arg = 3; break;
    }
}
__global__ void __launch_bounds__(512) yoco_fwd(Params p0) {
    extern __shared__ __attribute__((aligned(16))) unsigned char lds[];
    cg::grid_group grid = cg::this_grid();
    volatile LAS unsigned* bst = (volatile LAS unsigned*)((LAS unsigned char*)lds + (LDS_BYTES - 16));
    if (threadIdx.x == 0) { bst[0] = 0u; bst[1] = 0u; }
    __syncthreads();
    (void)xcd_barrier_post((unsigned*)(p0.ws + WS_BAR), bst);
    const int ph_hi = p0.ph_hi;
    for (int ph = p0.ph_lo; ph < ph_hi; ++ph) {
        int rph = ph; bool dry = false;
#ifdef PROBE_PH
        if (ph == PROBE_PH) dry = true;
        if (ph > PROBE_PH) rph = ph - 1;
#endif
        int type, arg; phase_desc(rph, type, arg);
        const __attribute__((address_space(4))) Params* pp = (const __attribute__((address_space(4))) Params*)__builtin_amdgcn_kernarg_segment_ptr();
        asm volatile("" : "+s"(pp));
        Params p;
#pragma unroll
        for (int i = 0; i < 15; ++i) p.in[i] = pp->in[i];
        p.out = pp->out; p.ws = pp->ws; p.ph_lo = 0; p.ph_hi = 0;
        int tid = threadIdx.x; asm volatile("" : "+v"(tid));
        const int lane = tid & 63, wave = __builtin_amdgcn_readfirstlane(tid >> 6);
        const int gw = blockIdx.x * 8 + wave, ngw = gridDim.x * 8;
        unsigned char* ws = p.ws;
        bf16* XN = (bf16*)(ws + WS_XN); bf16* XN3 = (bf16*)(ws + WS_XN3); bf16* HB = (bf16*)(ws + WS_H);
        if (type == T_CONV0) {
#ifndef SK_CONV
            convert_layer0(p, lds, gw, ngw, wave, lane);
#endif
#ifndef SK_RMS
            rms_rows(p.in[0], p.in[1], XN, nullptr, nullptr, gw, ngw, lane);
#endif
        } else if (type == T_RMS) {
#ifndef SK_RMS
            if (arg == 3) rms_rows(p.out, p.in[8], XN3, p.in[1] + 3 * DM, XN, gw, ngw, lane);
            else rms_rows(p.out, p.in[1] + arg * DM, XN, nullptr, nullptr, gw, ngw, lane);
#endif
        } else if (type == T_FFN_IN) {
            const size_t wo = arg == 0 ? WS_WIN0 : (arg == 1 ? WS_WIN1 : (arg == 2 ? WS_WIN2 : WS_WIN3));
            pg8::EpiSwiglu E{HB};
#ifndef SK_G1
            run_gemm(lds, XN, (const bf16*)(ws + wo), 2 * DFF, DM, E);
#endif
        } else if (type == T_RESID) {
            const bf16* A; const bf16* Bt; int K; const float* res = p.out; float scale = 0.5f;
            if (arg < 4) { A = HB; K = DFF; Bt = (const bf16*)(ws + (arg == 0 ? WS_WOUT0 : (arg == 1 ? WS_WOUT1 : (arg == 2 ? WS_WOUT2 : WS_WOUT3)))); if (arg == 0) res = p.in[0]; }
            else if (arg == 4) { A = (const bf16*)(ws + WS_QH); K = DM; Bt = (const bf16*)(ws + WS_WAOUT); scale = 1.0f;
#ifndef SK_CONV
            if (!dry) { convert_layer1(p, lds, gw, ngw, wave, lane); __syncthreads(); }
#endif
            }
            else { A = (const bf16*)(ws + WS_QH); K = DM; Bt = (const bf16*)(ws + WS_WO); scale = 1.0f; }
            if (arg == 3) {
                if (dry) scale = 0.f;
                pg8::EpiResid E{res, p.out, scale};
                run_gemm(lds, A, Bt, DM, K, E);
            } else {
                const float* g1 = p.in[1] + (arg == 0 ? 1 : (arg == 4 ? 2 : (arg == 1 ? 3 : (arg == 2 ? 4 : 5)))) * DM;
                const float* g2 = p.in[8];
#pragma unroll 1
                for (int half = 0; half < 2; ++half) {
                    pg8::EpiResidNorm<GridBarFn, WS_SSP, WS_XN, WS_XN3> E{res, p.out, ws, g1, g2, (unsigned*)(ws + WS_BAR), scale, half * (MTOK / 2), arg == 1 ? 1 : 0, (unsigned)(size_t)bst};
                    pg8::Gemm g{A + (size_t)half * (MTOK / 2) * K, Bt, MTOK / 2, DM, K}; pg8::StaticOrder S; S.init(MTOK / 2, DM, (int)gridDim.x, (int)blockIdx.x);
                    pg8::gemm_phase<decltype(E), pg8::StaticOrder, false, true>((LAS unsigned char*)lds, g, S, E);
                    __syncthreads();
                }
            }
        } else if (type == T_AIN) {
            pg8::EpiAin<WS_QH, WS_LF, WS_VH, WS_GH> E{ws, p.in[5]};
#ifndef SK_G3
            run_gemm(lds, XN, (const bf16*)(ws + WS_WAIN), 4096, DM, E);
#endif
        } else if (type == T_HA) {
#ifndef SK_HA
            hgrn_pass_a(p, lds);
#endif
        } else if (type == T_HB) {
#ifndef SK_HB
            hgrn_pass_b(p, dry);
#endif
        } else if (type == T_HC) {
#ifndef SK_HC
            hgrn_pass_c(p, lds, dry);
#endif
        } else if (type == T_QKV) {
#pragma unroll 1
            for (int j = 0; j < 2; ++j) {
                const bf16* A = j == 0 ? XN : XN3;
                const bf16* Bt = j == 0 ? (const bf16*)(ws + WS_WQ) + (size_t)arg * 1024 * DM : (const bf16*)(ws + WS_WKV) + (size_t)arg * 2048 * DM;
                pg8::EpiBf16 E{(bf16*)(ws + (j == 0 ? WS_QG : WS_KG)), DM, arg * 2};
                run_gemm(lds, A, Bt, j == 0 ? DM : 2 * DM, DM, E);
            }
        } else {
#ifndef SK_ATT
            attn_group(p, lds, arg);
#endif
        }
        if (ph + 1 < ph_hi) {
            if (ph == p0.ph_lo) grid.sync();
            else { XcdBarrier xb; xb.bar = (unsigned*)(ws + WS_BAR); xb.x = xb_xcc_id(); xb.st = bst; xcd_barrier(xb); }
        }
    }
}

extern "C" void kernel_launch(void* const* d_in, const int* in_sizes, int n_in, void* d_out, int out_size, void* d_ws, size_t ws_size, hipStream_t stream) {
    static int grid = 0;
    if (grid == 0) {
        if (n_in != 15 || out_size != MTOK * DM || ws_size < WS_END) { fprintf(stderr, "kernel_launch: unexpected shapes (n_in %d out %d ws %zu)\n", n_in, out_size, ws_size); grid = -1; return; }
        int dev = 0, cus = 0, per_cu = 0;
        hipGetDevice(&dev); hipDeviceGetAttribute(&cus, hipDeviceAttributeMultiprocessorCount, dev);
        hipFuncSetAttribute((const void*)yoco_fwd, hipFuncAttributeMaxDynamicSharedMemorySize, LDS_BYTES);
        hipOccupancyMaxActiveBlocksPerMultiprocessor(&per_cu, (const void*)yoco_fwd, 512, LDS_BYTES);
        if (per_cu < 1) per_cu = 1;
        (void)hipGetLastError();
        grid = cus * per_cu;
    }
    if (grid < 0) return;
    if (hipMemsetAsync((char*)d_ws, 0, 262144, stream) != hipSuccess) { fprintf(stderr, "kernel_launch: memset failed\n"); return; }
    Params p{};
    for (int i = 0; i < 15; ++i) p.in[i] = (const float*)d_in[i];
    p.out = (float*)d_out; p.ws = (unsigned char*)d_ws;
#if defined(MK_MULTI)
    for (int ph = 0; ph < NPH; ++ph) { p.ph_lo = ph; p.ph_hi = ph + 1; hipLaunchKernelGGL(yoco_fwd, dim3(grid), dim3(512), LDS_BYTES, stream, p); }
#else
#ifdef PROBE_PH
    p.ph_lo = 0; p.ph_hi = NPH + 1;
#else
    p.ph_lo = 0; p.ph_hi = NPH;
#endif
    void* args[] = {&p};
    hipError_t e = hipLaunchCooperativeKernel((const void*)yoco_fwd, dim3(grid), dim3(512), args, LDS_BYTES, stream);
    if (e != hipSuccess) fprintf(stderr, "cooperative launch failed: %s (grid %d)\n", hipGetErrorString(e), grid);
#endif
}
```

```cpp
#include <hip/hip_runtime.h>
#include <hip/hip_cooperative_groups.h>
#include <cstdio>
#include <cstdint>
namespace cg = cooperative_groups;
namespace pg8 {
#define PG8_LAS __attribute__((address_space(3)))
typedef unsigned short bf16_t;
typedef short bf16x8 __attribute__((ext_vector_type(8)));
typedef float f32x4 __attribute__((ext_vector_type(4)));
typedef unsigned u32x4 __attribute__((ext_vector_type(4)));
constexpr int BM = 256, BK = 64, HALF = 128, HTB = HALF * BK * 2  , STAGE_BYTES = 8 * HTB, NXCD = 8, WGM = 8;

__host__ __device__ __forceinline__ int lds_byte(int r, int c) { const int st = (r >> 4) * 2 + (c >> 5), rr = r & 15, cc = c & 31, ob = rr * 64 + cc * 2; return st * 1024 + (ob ^ (((ob >> 9) & 1) << 5)); }
__host__ __device__ __forceinline__ void stage_rc(int b, int& R, int& C) { const int st = b / 1024, sb = b % 1024, swz = sb ^ (((sb >> 9) & 1) << 5); R = (st >> 1) * 16 + swz / 64; C = (st & 1) * 32 + (swz % 64) / 2; }
__host__ __device__ __forceinline__ int perm32(int rho) { const int n = rho >> 4, i = rho & 15; return 8 * (i >> 2) + 4 * n + (i & 3); }

struct Unit { int pm, pn; };
struct Gemm { const bf16_t* A; const bf16_t* Bt; int M, N, K; };

struct StaticOrder {
    int nM, nN, nwg, G, c;
    __host__ __device__ void init(int M, int N, int G_, int c_) { nM = M / BM; nN = N / BM; nwg = nM * nN; G = G_; c = c_; }
    __host__ __device__ bool next(int i, Unit& u) const {
        const long L = (long)i * G + c; if (L >= nwg) return false;
        int wgid = (int)L; { const int q = nwg / NXCD, r = nwg % NXCD, xcd = wgid % NXCD, off = wgid / NXCD; wgid = (xcd < r ? xcd * (q + 1) : r * (q + 1) + (xcd - r) * q) + off; }
        const int nig = WGM * nN, gid = wgid / nig, fm = gid * WGM, gsz = (nM - fm) < WGM ? (nM - fm) : WGM;
        u.pm = fm + ((wgid % nig) % gsz); u.pn = (wgid % nig) / gsz; return true;
    }
    __device__ __forceinline__ void a_ready(const Unit&) const {}
    __device__ __forceinline__ void done(const Unit&) const {}
};

typedef float f32x2c_t __attribute__((ext_vector_type(2))); typedef __bf16 bf16x2c_t __attribute__((ext_vector_type(2)));
__device__ __forceinline__ unsigned cvt_pk_bf16(float lo, float hi) { const f32x2c_t v = {lo, hi}; const bf16x2c_t b = __builtin_convertvector(v, bf16x2c_t); return __builtin_bit_cast(unsigned, b); }
typedef float f32x2 __attribute__((ext_vector_type(2)));

__device__ __forceinline__ float silu_f(float x) { return x * __builtin_amdgcn_rcpf(1.0f + __expf(-x)); }

struct EpiBf16 {
    static constexpr bool PERM = true, AFTER_DRAIN = false;
    bf16_t* O; int ldc; int sh;
    __device__ __forceinline__ void operator()(const f32x4 (&acc)[2][2][4][2], const Unit& u, int wr, int wc, int fr, int fq) const {
        const int row0 = u.pm * BM + wr * 64 + fr; const int t = u.pn >> 2; const int col0 = (u.pn & 3) * BM + wc * 32 + 8 * fq;
        bf16_t* Ot = O + (size_t)t * 32768 * 1024;
#pragma unroll
        for (int ai = 0; ai < 2; ++ai)
#pragma unroll
            for (int m = 0; m < 4; ++m) { const int row = row0 + ai * HALF + m * 16;
                const int bb = row >> 14, s = row & 16383; const int prow = sh < 0 ? 0 : (((s & ((1 << sh) - 1)) << (14 - sh)) | (s >> sh));
#pragma unroll
                for (int bj = 0; bj < 2; ++bj) { const f32x4 v0 = acc[ai][bj][m][0], v1 = acc[ai][bj][m][1]; const int col = col0 + bj * HALF;
                    u32x4 w; w.x = cvt_pk_bf16(v0[0], v0[1]); w.y = cvt_pk_bf16(v0[2], v0[3]); w.z = cvt_pk_bf16(v1[0], v1[1]); w.w = cvt_pk_bf16(v1[2], v1[3]);
                    bf16_t* dst = sh < 0 ? Ot + (size_t)row * ldc + col : Ot + ((((size_t)(bb * 16 + (col >> 6))) << 14) + prow) * 64 + (col & 63);
                    *(u32x4*)dst = w; } }
    }
};

struct EpiSwiglu {
    static constexpr bool PERM = true, AFTER_DRAIN = false;
    bf16_t* H;
    __device__ __forceinline__ void operator()(const f32x4 (&acc)[2][2][4][2], const Unit& u, int wr, int wc, int fr, int fq) const {
        const int row0 = u.pm * BM + wr * 64 + fr; const int col0 = u.pn * HALF + wc * 32 + 8 * fq;
#pragma unroll
        for (int ai = 0; ai < 2; ++ai)
#pragma unroll
            for (int m = 0; m < 4; ++m) { bf16_t* rowp = H + (size_t)(row0 + ai * HALF + m * 16) * 2816 + col0;
                const f32x4 g0 = acc[ai][0][m][0], g1 = acc[ai][0][m][1], u0 = acc[ai][1][m][0], u1 = acc[ai][1][m][1];
                float h[8];
#pragma unroll
                for (int j = 0; j < 4; ++j) { h[j] = silu_f(g0[j]) * u0[j]; h[4 + j] = silu_f(g1[j]) * u1[j]; }
                u32x4 w; w.x = cvt_pk_bf16(h[0], h[1]); w.y = cvt_pk_bf16(h[2], h[3]); w.z = cvt_pk_bf16(h[4], h[5]); w.w = cvt_pk_bf16(h[6], h[7]);
                *(u32x4*)rowp = w; }
    }
};

struct EpiResid {
    static constexpr bool PERM = true, AFTER_DRAIN = false;
    const float* res; float* out; float scale;
    __device__ __forceinline__ void operator()(const f32x4 (&acc)[2][2][4][2], const Unit& u, int wr, int wc, int fr, int fq) const {
        const int row0 = u.pm * BM + wr * 64 + fr; const int col0 = u.pn * BM + wc * 32 + 8 * fq;
#pragma unroll
        for (int ai = 0; ai < 2; ++ai)
#pragma unroll
            for (int m = 0; m < 4; ++m) { const size_t off = (size_t)(row0 + ai * HALF + m * 16) * 1024 + col0;
#pragma unroll
                for (int bj = 0; bj < 2; ++bj) {
                    const f32x4 r0 = *(const f32x4*)(res + off + bj * HALF), r1 = *(const f32x4*)(res + off + bj * HALF + 4);
                    __builtin_nontemporal_store(r0 + acc[ai][bj][m][0] * scale, (f32x4*)(out + off + bj * HALF)); __builtin_nontemporal_store(r1 + acc[ai][bj][m][1] * scale, (f32x4*)(out + off + bj * HALF + 4));   } }
    }
};


template <class BarFn, size_t OSSP, size_t OXN, size_t OXN3> struct EpiResidNorm {
    static constexpr bool PERM = true, AFTER_DRAIN = true;
    const float* res; float* out; unsigned char* ws; const float* g1; const float* g2; unsigned* barw; float scale; int row_off; int dual; unsigned bst;
    __device__ __forceinline__ void fused(f32x4 (&acc)[2][2][4][2], const Unit& u, int wr, int wc, int fr, int fq, PG8_LAS unsigned char* lds, int wid, int lane) const {
        const int row0 = row_off + u.pm * BM + wr * 64 + fr; const int col0 = u.pn * BM + wc * 32 + 8 * fq;
        float* SSP = (float*)(ws + OSSP);
#pragma unroll
        for (int ai = 0; ai < 2; ++ai)
#pragma unroll
            for (int m = 0; m < 4; ++m) { const size_t off = (size_t)(row0 + ai * HALF + m * 16) * 1024 + col0; float ss = 0.f;
#pragma unroll
                for (int bj = 0; bj < 2; ++bj) {
                    const f32x4 r0 = *(const f32x4*)(res + off + bj * HALF), r1 = *(const f32x4*)(res + off + bj * HALF + 4);
                    const f32x4 x0 = r0 + acc[ai][bj][m][0] * scale, x1 = r1 + acc[ai][bj][m][1] * scale;
                    acc[ai][bj][m][0] = x0; acc[ai][bj][m][1] = x1;
                    ss += ((x0[0] * x0[0] + x0[1] * x0[1]) + (x0[2] * x0[2] + x0[3] * x0[3])) + ((x1[0] * x1[0] + x1[1] * x1[1]) + (x1[2] * x1[2] + x1[3] * x1[3])); }
                ss += __shfl_xor(ss, 16); ss += __shfl_xor(ss, 32);
                if (fq == 0) SSP[(size_t)(row0 + ai * HALF + m * 16) * 16 + u.pn * 4 + wc] = ss;
                if (m & 1) asm volatile("" ::: "memory"); }
        BarFn::sync(barw, bst);
        f32x4 ga[2][2], gb[2][2];
#pragma unroll
        for (int bj = 0; bj < 2; ++bj) { ga[bj][0] = *(const f32x4*)(g1 + col0 + bj * HALF); ga[bj][1] = *(const f32x4*)(g1 + col0 + bj * HALF + 4);
            gb[bj][0] = dual ? *(const f32x4*)(g2 + col0 + bj * HALF) : ga[bj][0]; gb[bj][1] = dual ? *(const f32x4*)(g2 + col0 + bj * HALF + 4) : ga[bj][1]; }
        bf16_t* XN = (bf16_t*)(ws + OXN); bf16_t* XN3 = (bf16_t*)(ws + OXN3);
#pragma unroll
        for (int ai = 0; ai < 2; ++ai)
#pragma unroll
            for (int m = 0; m < 4; ++m) { const int row = row0 + ai * HALF + m * 16; const size_t off = (size_t)row * 1024 + col0;
                const f32x4* sp = (const f32x4*)(SSP + (size_t)row * 16); const f32x4 pa = sp[0], pb = sp[1], pc = sp[2], pd = sp[3];
                const float s = (((pa[0] + pa[1]) + (pa[2] + pa[3])) + ((pb[0] + pb[1]) + (pb[2] + pb[3]))) + (((pc[0] + pc[1]) + (pc[2] + pc[3])) + ((pd[0] + pd[1]) + (pd[2] + pd[3])));
                const float rstd = rsqrtf(s * (1.0f / 1024.0f) + 1e-6f);
#pragma unroll
                for (int bj = 0; bj < 2; ++bj) { const f32x4 x0 = acc[ai][bj][m][0], x1 = acc[ai][bj][m][1];
                    __builtin_nontemporal_store(x0, (f32x4*)(out + off + bj * HALF)); __builtin_nontemporal_store(x1, (f32x4*)(out + off + bj * HALF + 4));
                    const f32x4 y0 = x0 * rstd, y1 = x1 * rstd; const f32x4 a0 = y0 * ga[bj][0], a1 = y1 * ga[bj][1];
                    u32x4 w; w.x = cvt_pk_bf16(a0[0], a0[1]); w.y = cvt_pk_bf16(a0[2], a0[3]); w.z = cvt_pk_bf16(a1[0], a1[1]); w.w = cvt_pk_bf16(a1[2], a1[3]);
                    *(u32x4*)(XN + off + bj * HALF) = w;
                    if (dual) { const f32x4 b0 = y0 * gb[bj][0], b1 = y1 * gb[bj][1];
                        u32x4 w2; w2.x = cvt_pk_bf16(b0[0], b0[1]); w2.y = cvt_pk_bf16(b0[2], b0[3]); w2.z = cvt_pk_bf16(b1[0], b1[1]); w2.w = cvt_pk_bf16(b1[2], b1[3]);
                        __builtin_nontemporal_store(w2, (u32x4*)(XN3 + off + bj * HALF));   } }
                if (m & 1) asm volatile("" ::: "memory"); }
    }
};

__device__ __forceinline__ float lbf(float l0, float l1) { return __builtin_amdgcn_rcpf(1.0f + __expf(l1 - l0)); }
__device__ __forceinline__ float lff(float lb, float z) { return __log2f(lb + (1.0f - lb) * __builtin_amdgcn_rcpf(1.0f + __expf(-z))); }
template <size_t OQ, size_t OLF, size_t OV, size_t OG> struct EpiAin {
    static constexpr bool PERM = true, AFTER_DRAIN = false;
    unsigned char* ws; const float* lbl;
    __device__ __forceinline__ void operator()(const f32x4 (&acc)[2][2][4][2], const Unit& u, int wr, int wc, int fr, int fq) const {
        const int type = u.pn >> 2; const int row0 = u.pm * BM + wr * 64 + fr; const int col0 = (u.pn & 3) * BM + wc * 32 + 8 * fq;
        if (type == 1) {
#pragma unroll
            for (int bj = 0; bj < 2; ++bj) { const int c = col0 + bj * HALF;
                const f32x4 la0 = *(const f32x4*)(lbl + c), la1 = *(const f32x4*)(lbl + c + 4), lc0 = *(const f32x4*)(lbl + 1024 + c), lc1 = *(const f32x4*)(lbl + 1024 + c + 4);
                f32x4 lb0, lb1;
                lb0.x = lbf(la0.x, lc0.x); lb0.y = lbf(la0.y, lc0.y); lb0.z = lbf(la0.z, lc0.z); lb0.w = lbf(la0.w, lc0.w);
                lb1.x = lbf(la1.x, lc1.x); lb1.y = lbf(la1.y, lc1.y); lb1.z = lbf(la1.z, lc1.z); lb1.w = lbf(la1.w, lc1.w);
#pragma unroll
                for (int ai = 0; ai < 2; ++ai)
#pragma unroll
                    for (int m = 0; m < 4; ++m) { bf16_t* rowp = (bf16_t*)(ws + OLF) + (size_t)(row0 + ai * HALF + m * 16) * 1024 + c;
                        const f32x4 z0 = acc[ai][bj][m][0], z1 = acc[ai][bj][m][1]; f32x4 o0, o1;
                        o0.x = lff(lb0.x, z0.x); o0.y = lff(lb0.y, z0.y); o0.z = lff(lb0.z, z0.z); o0.w = lff(lb0.w, z0.w);
                        o1.x = lff(lb1.x, z1.x); o1.y = lff(lb1.y, z1.y); o1.z = lff(lb1.z, z1.z); o1.w = lff(lb1.w, z1.w);
                        u32x4 w; w.x = cvt_pk_bf16(o0.x, o0.y); w.y = cvt_pk_bf16(o0.z, o0.w); w.z = cvt_pk_bf16(o1.x, o1.y); w.w = cvt_pk_bf16(o1.z, o1.w);
                        *(u32x4*)rowp = w; } }
        } else {
            bf16_t* base = (bf16_t*)(ws + (type == 0 ? OQ : (type == 2 ? OV : OG))); const bool act = type != 2;
#pragma unroll
            for (int ai = 0; ai < 2; ++ai)
#pragma unroll
                for (int m = 0; m < 4; ++m) { bf16_t* rowp = base + (size_t)(row0 + ai * HALF + m * 16) * 1024 + col0;
#pragma unroll
                    for (int bj = 0; bj < 2; ++bj) { f32x4 v0 = acc[ai][bj][m][0], v1 = acc[ai][bj][m][1];
                        if (act) {
#pragma unroll
                            for (int j = 0; j < 4; ++j) { v0[j] = silu_f(v0[j]); v1[j] = silu_f(v1[j]); } }
                        u32x4 w; w.x = cvt_pk_bf16(v0[0], v0[1]); w.y = cvt_pk_bf16(v0[2], v0[3]); w.z = cvt_pk_bf16(v1[0], v1[1]); w.w = cvt_pk_bf16(v1[2], v1[3]);
                        if (act) __builtin_nontemporal_store(w, (u32x4*)(rowp + bj * HALF)); else *(u32x4*)(rowp + bj * HALF) = w; } }
        }
    }
};

template <class Epi, class Sched, bool ALIGN_EPI = false, bool SP2 = false>
__device__ __forceinline__ void gemm_phase(PG8_LAS unsigned char* lds, const Gemm g, const Sched& S, const Epi& E) {
    int tid = threadIdx.x; asm volatile("" : "+v"(tid));
    const int wid = __builtin_amdgcn_readfirstlane(tid >> 6), lane = tid & 63, wr = wid >> 2, wc = wid & 3, fr = lane & 15, fq = lane >> 4;
    const int K = g.K, nt = K / BK;
    unsigned voffA[2], voffB[2];
#pragma unroll
    for (int i = 0; i < 2; ++i) { int R, C; stage_rc(tid * 16 + i * 8192, R, C); const int Rb = Epi::PERM ? ((R & ~31) + perm32(R & 31)) : R;
        voffA[i] = (unsigned)(R * K + C) * 2u; voffB[i] = (unsigned)(Rb * K + C) * 2u; }
    const size_t kstep = (size_t)(BK * 2);
    const size_t hstep = (size_t)HALF * K * 2;
    const size_t tstep = 2 * hstep;
    const unsigned ldsw = (unsigned)wid * 1024u;
    const int aoff = lds_byte(wr * 64 + fr, fq * 8), boff = lds_byte(wc * 32 + fr, fq * 8);
#define PG8_SA(b, h) (((b) * 2 + (h)) * HTB)
#define PG8_SB(b, h) ((4 + (b) * 2 + (h)) * HTB)
#define PG8_STAGE(bufoff, gbase, voff) do { _Pragma("unroll") for (int _i = 0; _i < 2; ++_i) \
        __builtin_amdgcn_global_load_lds((const unsigned*)((const char*)(gbase) + (voff)[_i]), (PG8_LAS unsigned*)(lds + (bufoff) + ldsw + _i * 8192), 16, 0, 0); } while (0)
#define PG8_LDA(dst, b, h) do { _Pragma("unroll") for (int m = 0; m < 4; ++m) _Pragma("unroll") for (int k = 0; k < 2; ++k) dst[m][k] = *(const PG8_LAS bf16x8*)(lds + PG8_SA(b, h) + aoff + m * 2048 + k * 1024); } while (0)
#define PG8_LDB(dst, b, h) do { _Pragma("unroll") for (int n = 0; n < 2; ++n) _Pragma("unroll") for (int k = 0; k < 2; ++k) dst[n][k] = *(const PG8_LAS bf16x8*)(lds + PG8_SB(b, h) + boff + n * 2048 + k * 1024); } while (0)
#define PG8_MMA(ai, bj, At, Bt) do { __builtin_amdgcn_s_setprio(1); _Pragma("unroll") for (int m = 0; m < 4; ++m) _Pragma("unroll") for (int n = 0; n < 2; ++n) _Pragma("unroll") for (int k = 0; k < 2; ++k) \
        acc[ai][bj][m][n] = __builtin_amdgcn_mfma_f32_16x16x32_bf16(Bt[n][k], At[m][k], acc[ai][bj][m][n], 0, 0, 0); __builtin_amdgcn_s_setprio(0); } while (0)
#define PG8_WAIT_V(n) asm volatile("s_waitcnt vmcnt(" #n ")" ::: "memory")
#define PG8_WAIT_L(n) asm volatile("s_waitcnt lgkmcnt(" #n ")" ::: "memory")
#define PG8_BAR __builtin_amdgcn_s_barrier()
#define PG8_SCHED __builtin_amdgcn_sched_barrier(0)
    Unit cur, nxt; int ui = 0;
    if (!S.next(0, cur)) return;
    f32x4 acc[2][2][4][2];
#pragma unroll
    for (int a = 0; a < 2; ++a)
#pragma unroll
        for (int b = 0; b < 2; ++b)
#pragma unroll
            for (int m = 0; m < 4; ++m)
#pragma unroll
                for (int n = 0; n < 2; ++n) acc[a][b][m][n] = (f32x4){0.f, 0.f, 0.f, 0.f};
    bf16x8 At[4][2], B0[2][2], B1[2][2];
    const char* cA = (const char*)g.A + (size_t)cur.pm * tstep; const char* cB = (const char*)g.Bt + (size_t)cur.pn * tstep;
    S.a_ready(cur);
    if constexpr (SP2) {
        PG8_STAGE(PG8_SB(0, 0), cB, voffB); PG8_STAGE(PG8_SB(0, 1), cB + hstep, voffB); PG8_STAGE(PG8_SA(0, 0), cA, voffA); PG8_STAGE(PG8_SA(0, 1), cA + hstep, voffA);
        if (wr == 1) PG8_BAR;
        PG8_WAIT_V(2); PG8_BAR;
        PG8_STAGE(PG8_SB(1, 0), cB + kstep, voffB); PG8_STAGE(PG8_SA(1, 0), cA + kstep, voffA); PG8_STAGE(PG8_SB(1, 1), cB + hstep + kstep, voffB);
        PG8_WAIT_V(6); PG8_BAR;
    } else {
        PG8_STAGE(PG8_SB(0, 0), cB, voffB); PG8_STAGE(PG8_SA(0, 0), cA, voffA); PG8_STAGE(PG8_SB(0, 1), cB + hstep, voffB); PG8_STAGE(PG8_SA(0, 1), cA + hstep, voffA);
        if (wr == 1) PG8_BAR;
        PG8_WAIT_V(4); PG8_BAR;
        PG8_STAGE(PG8_SB(1, 0), cB + kstep, voffB); PG8_STAGE(PG8_SA(1, 0), cA + kstep, voffA); PG8_STAGE(PG8_SB(1, 1), cB + hstep + kstep, voffB);
        PG8_WAIT_V(6); PG8_BAR;
    }
    for (;;) {
        const bool has_next = S.next(ui + 1, nxt);
        const char* nA = has_next ? (const char*)g.A + (size_t)nxt.pm * tstep : cA; const char* nB = has_next ? (const char*)g.Bt + (size_t)nxt.pn * tstep : cB;
        for (int t = 0; t < nt; t += 2) {
            const bool last = (t == nt - 2);
            const char* a1 = cA + (size_t)(t + 1) * kstep;
            const char* a2 = last ? nA : cA + (size_t)(t + 2) * kstep; const char* b2 = last ? nB : cB + (size_t)(t + 2) * kstep;
            const char* a3 = a2 + kstep; const char* b3 = b2 + kstep;
            if (last && has_next) S.a_ready(nxt);
            if constexpr (SP2) {
            PG8_LDB(B0, 0, 0); PG8_LDB(B1, 0, 1); PG8_SCHED; PG8_LDA(At, 0, 0); PG8_STAGE(PG8_SA(1, 1), a1 + hstep, voffA);
            PG8_WAIT_V(8); PG8_WAIT_L(0); PG8_BAR; PG8_MMA(0, 0, At, B0); PG8_MMA(0, 1, At, B1); PG8_BAR; PG8_SCHED;
            PG8_LDA(At, 0, 1); PG8_STAGE(PG8_SB(0, 0), b2, voffB); PG8_STAGE(PG8_SB(0, 1), b2 + hstep, voffB); PG8_STAGE(PG8_SA(0, 0), a2, voffA);
            PG8_WAIT_V(8); PG8_WAIT_L(0); PG8_BAR; PG8_MMA(1, 0, At, B0); PG8_MMA(1, 1, At, B1); PG8_BAR; PG8_SCHED;
            PG8_LDB(B0, 1, 0); PG8_LDB(B1, 1, 1); PG8_SCHED; PG8_LDA(At, 1, 0); PG8_STAGE(PG8_SA(0, 1), a2 + hstep, voffA);
            PG8_WAIT_V(8); PG8_WAIT_L(0); PG8_BAR; PG8_MMA(0, 0, At, B0); PG8_MMA(0, 1, At, B1); PG8_BAR; PG8_SCHED;
            PG8_LDA(At, 1, 1); PG8_STAGE(PG8_SB(1, 0), b3, voffB); PG8_STAGE(PG8_SB(1, 1), b3 + hstep, voffB); PG8_STAGE(PG8_SA(1, 0), a3, voffA);
            PG8_WAIT_V(8); PG8_WAIT_L(0); PG8_BAR; PG8_MMA(1, 0, At, B0); PG8_MMA(1, 1, At, B1); PG8_BAR; PG8_SCHED;
            } else {
            PG8_LDB(B0, 0, 0); PG8_SCHED; PG8_LDA(At, 0, 0); PG8_STAGE(PG8_SA(1, 1), a1 + hstep, voffA);
            PG8_WAIT_L(8); PG8_BAR; PG8_WAIT_L(0); PG8_MMA(0, 0, At, B0); PG8_BAR; PG8_SCHED;
            PG8_LDB(B1, 0, 1); PG8_STAGE(PG8_SB(0, 0), b2, voffB);
            PG8_BAR; PG8_WAIT_L(0); PG8_MMA(0, 1, At, B1); PG8_BAR;
            PG8_LDA(At, 0, 1); PG8_STAGE(PG8_SA(0, 0), a2, voffA);
            PG8_BAR; PG8_WAIT_L(0); PG8_MMA(1, 0, At, B0); PG8_BAR; PG8_SCHED;
            PG8_STAGE(PG8_SB(0, 1), b2 + hstep, voffB);
            PG8_WAIT_V(6); PG8_BAR; PG8_MMA(1, 1, At, B1); PG8_BAR;
            PG8_LDB(B0, 1, 0); PG8_SCHED; PG8_LDA(At, 1, 0); PG8_STAGE(PG8_SA(0, 1), a2 + hstep, voffA);
            PG8_WAIT_L(8); PG8_BAR; PG8_WAIT_L(0); PG8_MMA(0, 0, At, B0); PG8_BAR; PG8_SCHED;
            PG8_LDB(B1, 1, 1); PG8_STAGE(PG8_SB(1, 0), b3, voffB);
            PG8_BAR; PG8_WAIT_L(0); PG8_MMA(0, 1, At, B1); PG8_BAR;
            PG8_LDA(At, 1, 1); PG8_STAGE(PG8_SA(1, 0), a3, voffA);
            PG8_BAR; PG8_WAIT_L(0); PG8_MMA(1, 0, At, B0); PG8_BAR; PG8_SCHED;
            PG8_STAGE(PG8_SB(1, 1), b3 + hstep, voffB);
            PG8_WAIT_V(6); PG8_BAR; PG8_MMA(1, 1, At, B1); PG8_BAR;
            }
        }
        if constexpr (ALIGN_EPI) { if (wr == 0) PG8_BAR; }
        if constexpr (!Epi::AFTER_DRAIN) { E(acc, cur, wr, wc, fr, fq); S.done(cur); }
        if (!has_next) break;
#pragma unroll
        for (int a = 0; a < 2; ++a)
#pragma unroll
            for (int b = 0; b < 2; ++b)
#pragma unroll
                for (int m = 0; m < 4; ++m)
#pragma unroll
                    for (int n = 0; n < 2; ++n) acc[a][b][m][n] = (f32x4){0.f, 0.f, 0.f, 0.f};
        cur = nxt; cA = nA; cB = nB; ++ui;
        if constexpr (ALIGN_EPI) { if (wr == 1) PG8_BAR; }
    }
    PG8_WAIT_V(0);
    if constexpr (!ALIGN_EPI) { if (wr == 0) PG8_BAR; }
    PG8_BAR;
    if constexpr (Epi::AFTER_DRAIN) { E.fused(acc, cur, wr, wc, fr, fq, lds, wid, lane); S.done(cur); }
#undef PG8_SA
#undef PG8_SB
#undef PG8_STAGE
#undef PG8_LDA
#undef PG8_LDB
#undef PG8_MMA
#undef PG8_WAIT_V
#undef PG8_WAIT_L
#undef PG8_BAR
#undef PG8_SCHED
}
}

constexpr int BATCH = 2, SEQ = 16384, DM = 1024, DFF = 2816, MTOK = BATCH * SEQ;
constexpr int NCHUNK = SEQ / 64;
constexpr float EPS = 1e-6f;
constexpr float LOG2E = 1.4426950408889634f, LN2 = 0.6931471805599453f;
constexpr size_t MiB = 1u << 20;
constexpr size_t WS_WIN0 = 1 * MiB, WS_WIN1 = 12 * MiB, WS_WOUT0 = 23 * MiB, WS_WOUT1 = 23 * MiB + 5767168, WS_WAIN = 34 * MiB, WS_WAOUT = 42 * MiB;
constexpr size_t WS_XN = 44 * MiB, WS_XN3 = 108 * MiB;
constexpr size_t WS_ST = 44 * MiB;
constexpr size_t WS_QH = 172 * MiB;
constexpr size_t WS_VH = 236 * MiB, WS_GH = 300 * MiB, WS_LF = 364 * MiB;
constexpr size_t WS_DC = 492 * MiB, WS_LSE = 494 * MiB, WS_SSP = 496 * MiB, WS_END = 498 * MiB;
constexpr size_t WS_WIN2 = 236 * MiB, WS_WIN3 = 247 * MiB, WS_WOUT2 = 258 * MiB, WS_WOUT3 = 258 * MiB + 5767168, WS_WKV = 269 * MiB, WS_WQ = 281 * MiB, WS_WO = 287 * MiB;
constexpr size_t WS_H = 289 * MiB;
constexpr size_t WS_QG = 289 * MiB, WS_KG = 353 * MiB, WS_VG = 417 * MiB;
constexpr size_t WS_BAR = 65536;
constexpr int LDS_BYTES = 155648;

#define LAS __attribute__((address_space(3)))
typedef unsigned short bf16;
typedef unsigned v4u __attribute__((ext_vector_type(4)));
typedef unsigned v2u __attribute__((ext_vector_type(2)));
typedef float f32x4 __attribute__((ext_vector_type(4)));
#define LDS_WAIT() asm volatile("s_waitcnt lgkmcnt(0)" ::: "memory")
__device__ __forceinline__ float bf2f(unsigned b) { return __uint_as_float(b << 16); }
__device__ __forceinline__ unsigned f2bf(float f) { unsigned u = __float_as_uint(f); return (u + 0x7fffu + ((u >> 16) & 1u)) >> 16; }
typedef float f32x2_t __attribute__((ext_vector_type(2))); typedef __bf16 bf16x2_t __attribute__((ext_vector_type(2)));
__device__ __forceinline__ unsigned pk2(float lo, float hi) { const f32x2_t v = {lo, hi}; const bf16x2_t b = __builtin_convertvector(v, bf16x2_t); return __builtin_bit_cast(unsigned, b); }
__device__ __forceinline__ float ex2(float x) { return __builtin_amdgcn_exp2f(x); }
__device__ __forceinline__ float wave_sum(float v) {
#pragma unroll
    for (int o = 1; o < 64; o <<= 1) v += __shfl_xor(v, o);
    return v;
}

__constant__ unsigned char T5_BUCKET[3][132] = {
 {0,1,2,3,4,5,6,7,8,9,10,11,12,13,14,15,16,16,16,16,16,16,17,17,17,17,17,17,17,17,18,18,18,18,18,18,18,18,18,18,19,19,19,19,19,19,19,19,19,19,19,19,19,19,20,20,20,20,20,20,20,20,20,20,20,20,20,20,20,20,20,20,20,21,21,21,21,21,21,21,21,21,21,21,21,21,21,21,21,21,21,21,21,21,21,21,21,21,21,22,22,22,22,22,22,22,22,22,22,22,22,22,22,22,22,22,22,22,22,22,22,22,22,22,22,22,22,22,22,0,0,0},
 {0,4,8,12,16,16,17,17,18,18,19,19,19,19,20,20,20,20,20,21,21,21,21,21,21,22,22,22,22,22,22,22,22,22,23,23,23,23,23,23,23,23,23,23,23,23,24,24,24,24,24,24,24,24,24,24,24,24,24,24,24,24,25,25,25,25,25,25,25,25,25,25,25,25,25,25,25,25,25,25,25,25,25,26,26,26,26,26,26,26,26,26,26,26,26,26,26,26,26,26,26,26,26,26,26,26,26,26,26,26,26,26,26,27,27,27,27,27,27,27,27,27,27,27,27,27,27,27,27,0,0,0},
 {0,16,18,19,20,21,21,22,22,23,23,23,24,24,24,24,25,25,25,25,25,26,26,26,26,26,26,26,26,27,27,27,27,27,27,27,27,27,27,28,28,28,28,28,28,28,28,28,28,28,28,28,29,29,29,29,29,29,29,29,29,29,29,29,29,29,29,29,29,29,30,30,30,30,30,30,30,30,30,30,30,30,30,30,30,30,30,30,30,30,30,30,30,30,30,31,31,31,31,31,31,31,31,31,31,31,31,31,31,31,31,31,31,31,31,31,31,31,31,31,31,31,31,31,31,31,31,31,31,0,0,0}};

struct Params { const float* in[15]; float* out; unsigned char* ws; int ph_lo, ph_hi; };

__device__ __forceinline__ void transpose_item(const float* __restrict__ W, int K, int N, bf16* WT, int mode, float* scr, int item, int lane) {
    const int nblk = N / 32, kb = item / nblk, nb = item % nblk, k0 = 64 * kb, n0 = 32 * nb;
#pragma unroll 8
    for (int i = 0; i < 32; ++i) { const int kk = 2 * i + (lane >> 5); scr[kk * 33 + (lane & 31)] = __builtin_nontemporal_load(W + (size_t)(k0 + kk) * N + n0 + (lane & 31)); }
    LDS_WAIT();
    int drow0 = n0;
    if ((mode & 3) == 1) { const int isup = n0 >= DFF ? 1 : 0; const int j0 = n0 - isup * DFF; drow0 = (j0 >> 7) * 256 + isup * 128 + (j0 & 127); }
    if ((mode & 3) == 2) { const int kv = n0 >= 3072 ? 1 : 0; const int c = n0 - kv * 3072; drow0 = (c >> 10) * 2048 + kv * 1024 + (c & 1023); }
    const int c = lane & 7;
#pragma unroll
    for (int j = 0; j < 4; ++j) { const int n = (lane >> 3) + 8 * j; const float* s = scr + (8 * c) * 33 + n;
        v4u o; o.x = pk2(s[0 * 33], s[1 * 33]); o.y = pk2(s[2 * 33], s[3 * 33]); o.z = pk2(s[4 * 33], s[5 * 33]); o.w = pk2(s[6 * 33], s[7 * 33]);
        if (mode & 4) __builtin_nontemporal_store(o, (v4u*)(WT + (size_t)(drow0 + n) * K + k0 + 8 * c)); else *(v4u*)(WT + (size_t)(drow0 + n) * K + k0 + 8 * c) = o; }
    LDS_WAIT();
}
constexpr int IT_IN = 16 * 176, IT_OUT = 44 * 32, IT_AIN = 16 * 128, IT_SQ = 16 * 32, IT_KV = 16 * 192, IT_Q = 16 * 96;
__device__ __forceinline__ void convert_layer0(const Params& p, unsigned char* lds, int gw, int ngw, int wave, int lane) {
    float* scr = (float*)(lds + wave * 16384); unsigned char* ws = p.ws;
    constexpr int NIT = 2 * IT_IN + 2 * IT_OUT + IT_AIN + IT_SQ;
    for (int it = gw; it < NIT; it += ngw) { int r = it;
        if (r < IT_IN) { transpose_item(p.in[2], DM, 2 * DFF, (bf16*)(ws + WS_WIN0), 1, scr, r, lane); continue; } r -= IT_IN;
        if (r < IT_IN) { transpose_item(p.in[2] + (size_t)1 * DM * 2 * DFF, DM, 2 * DFF, (bf16*)(ws + WS_WIN1), 5, scr, r, lane); continue; } r -= IT_IN;
        if (r < IT_OUT) { transpose_item(p.in[3], DFF, DM, (bf16*)(ws + WS_WOUT0), 0, scr, r, lane); continue; } r -= IT_OUT;
        if (r < IT_OUT) { transpose_item(p.in[3] + (size_t)1 * DFF * DM, DFF, DM, (bf16*)(ws + WS_WOUT1), 4, scr, r, lane); continue; } r -= IT_OUT;
        if (r < IT_AIN) { transpose_item(p.in[4], DM, 4096, (bf16*)(ws + WS_WAIN), 4, scr, r, lane); continue; } r -= IT_AIN;
        transpose_item(p.in[7], DM, DM, (bf16*)(ws + WS_WAOUT), 4, scr, r, lane);
    }
}
__device__ __forceinline__ void convert_layer1(const Params& p, unsigned char* lds, int gw, int ngw, int wave, int lane) {
    float* scr = (float*)(lds + wave * 16384); unsigned char* ws = p.ws;
    constexpr int NIT = 2 * IT_IN + 2 * IT_OUT + IT_KV + IT_Q + IT_SQ;
    for (int it = gw; it < NIT; it += ngw) { int r = it;
        if (r < IT_IN) { transpose_item(p.in[2] + (size_t)2 * DM * 2 * DFF, DM, 2 * DFF, (bf16*)(ws + WS_WIN2), 5, scr, r, lane); continue; } r -= IT_IN;
        if (r < IT_IN) { transpose_item(p.in[2] + (size_t)3 * DM * 2 * DFF, DM, 2 * DFF, (bf16*)(ws + WS_WIN3), 5, scr, r, lane); continue; } r -= IT_IN;
        if (r < IT_OUT) { transpose_item(p.in[3] + (size_t)2 * DFF * DM, DFF, DM, (bf16*)(ws + WS_WOUT2), 4, scr, r, lane); continue; } r -= IT_OUT;
        if (r < IT_OUT) { transpose_item(p.in[3] + (size_t)3 * DFF * DM, DFF, DM, (bf16*)(ws + WS_WOUT3), 4, scr, r, lane); continue; } r -= IT_OUT;
        if (r < IT_KV) { transpose_item(p.in[9], DM, 6144, (bf16*)(ws + WS_WKV), 6, scr, r, lane); continue; } r -= IT_KV;
        if (r < IT_Q) { transpose_item(p.in[11], DM, 3072, (bf16*)(ws + WS_WQ), 4, scr, r, lane); continue; } r -= IT_Q;
        transpose_item(p.in[13], DM, DM, (bf16*)(ws + WS_WO), 4, scr, r, lane);
    }
}

__device__ __forceinline__ void rms_rows(const float* x, const float* g1, bf16* o1, const float* g2, bf16* o2, int gw, int ngw, int lane) {
    f32x4 ga[4], gb[4];
#pragma unroll
    for (int j = 0; j < 4; ++j) { ga[j] = ((const f32x4*)g1)[lane + 64 * j]; gb[j] = g2 ? ((const f32x4*)g2)[lane + 64 * j] : ga[j]; }
    for (int m = gw; m < MTOK; m += ngw) {
        const f32x4* xr = (const f32x4*)(x + (size_t)m * DM) + lane; f32x4 v[4]; float s = 0.f;
#pragma unroll
        for (int j = 0; j < 4; ++j) { v[j] = __builtin_nontemporal_load(xr + 64 * j); s += (v[j].x * v[j].x + v[j].y * v[j].y) + (v[j].z * v[j].z + v[j].w * v[j].w); }
        const float rstd = rsqrtf(wave_sum(s) * (1.0f / DM) + EPS);
        v2u* q1 = (v2u*)(o1 + (size_t)m * DM) + lane;
#pragma unroll
        for (int j = 0; j < 4; ++j) { const f32x4 y = v[j] * rstd; v2u w; w.x = pk2(y.x * ga[j].x, y.y * ga[j].y); w.y = pk2(y.z * ga[j].z, y.w * ga[j].w); q1[64 * j] = w; }
        if (g2) { v2u* q2 = (v2u*)(o2 + (size_t)m * DM) + lane;
#pragma unroll
            for (int j = 0; j < 4; ++j) { const f32x4 y = v[j] * rstd; v2u w; w.x = pk2(y.x * gb[j].x, y.y * gb[j].y); w.y = pk2(y.z * gb[j].z, y.w * gb[j].w); q2[64 * j] = w; } }
    }
}

constexpr int RS = 272, VS = 144;
constexpr int A_KH = 0, A_VT = A_KH + 128 * VS, A_TOT = A_VT + 128 * VS;
constexpr int C_QT = 0, C_QP = C_QT + 64 * RS, C_KT = C_QP + 64 * RS, C_VT = C_KT + 160 * RS, C_ST = C_VT + 128 * VS, C_TOT = C_ST + 128 * RS, C_PART = C_TOT + 4096, C_END = C_PART + 512;
static_assert(C_END <= LDS_BYTES, "pass C LDS map");
__device__ __forceinline__ void hgrn_stage_vt(unsigned char* Vt, const v4u we, const v4u wo, int tid) {
    const int tp = tid & 31, c8 = tid >> 5;
    unsigned char* vd = Vt + (8 * c8) * VS + 4 * tp;
    *(unsigned*)(vd + 0 * VS) = (we.x & 0xffffu) | (wo.x << 16); *(unsigned*)(vd + 1 * VS) = (we.x >> 16) | (wo.x & 0xffff0000u);
    *(unsigned*)(vd + 2 * VS) = (we.y & 0xffffu) | (wo.y << 16); *(unsigned*)(vd + 3 * VS) = (we.y >> 16) | (wo.y & 0xffff0000u);
    *(unsigned*)(vd + 4 * VS) = (we.z & 0xffffu) | (wo.z << 16); *(unsigned*)(vd + 5 * VS) = (we.z >> 16) | (wo.z & 0xffff0000u);
    *(unsigned*)(vd + 6 * VS) = (we.w & 0xffffu) | (wo.w << 16); *(unsigned*)(vd + 7 * VS) = (we.w >> 16) | (wo.w & 0xffff0000u);
}
__device__ __forceinline__ void hgrn_pass_a(const Params& p, unsigned char* lds) {
    int tid = threadIdx.x; asm volatile("" : "+v"(tid));
    const int lane = tid & 63, hs = __builtin_amdgcn_readfirstlane(tid >> 6), dp = lane, l15 = lane & 15, q4 = lane >> 4;
    unsigned char* ws = p.ws;
    unsigned char* Kh = lds + A_KH; unsigned char* Vt = lds + A_VT; float* tot = (float*)(lds + A_TOT);
    const bf16* LF = (const bf16*)(ws + WS_LF); const bf16* VH = (const bf16*)(ws + WS_VH); bf16* ST = (bf16*)(ws + WS_ST); float* DC = (float*)(ws + WS_DC);
    unsigned rlf[8]; v4u rve, rvo;
#define HA_LOAD(U) do { const int bh_ = (U) / NCHUNK, c_ = (U) % NCHUNK; const size_t r0_ = (size_t)(bh_ >> 3) * SEQ + (size_t)c_ * 64; const int h_ = bh_ & 7; \
        _Pragma("unroll") for (int u = 0; u < 8; ++u) rlf[u] = *(const unsigned*)(LF + (r0_ + 8 * hs + u) * DM + h_ * 128 + 2 * dp); \
        const size_t vo_ = (r0_ + 2 * (tid & 31)) * DM + h_ * 128 + (tid >> 5) * 8; rve = *(const v4u*)(VH + vo_); rvo = *(const v4u*)(VH + vo_ + DM); } while (0)
#define HG_UNIT(li) ((((li) & 15) * NCHUNK) + ((li) >> 4))
    if ((int)blockIdx.x < 16 * NCHUNK) HA_LOAD(HG_UNIT((int)blockIdx.x));
    for (int li = blockIdx.x; li < 16 * NCHUNK; li += gridDim.x) { const int unit = HG_UNIT(li);
        __syncthreads();
        hgrn_stage_vt(Vt, rve, rvo, tid);
        float c0[8], c1[8], k0[8], k1[8]; float run0 = 0.f, run1 = 0.f;
#pragma unroll
        for (int u = 0; u < 8; ++u) { const float x0 = bf2f(rlf[u] & 0xffffu), x1 = bf2f(rlf[u] >> 16);
            k0[u] = 1.0f - ex2(x0); k1[u] = 1.0f - ex2(x1); run0 += x0; run1 += x1; c0[u] = run0; c1[u] = run1; }
        tot[hs * 128 + 2 * dp] = run0; tot[hs * 128 + 2 * dp + 1] = run1;
        if (li + (int)gridDim.x < 16 * NCHUNK) HA_LOAD(HG_UNIT(li + (int)gridDim.x));
        __syncthreads();
        float suf0 = 0.f, suf1 = 0.f;
#pragma unroll
        for (int hh = 1; hh < 8; ++hh) { const float t0 = tot[hh * 128 + 2 * dp], t1 = tot[hh * 128 + 2 * dp + 1]; if (hh > hs) { suf0 += t0; suf1 += t1; } }
        if (hs == 0) { DC[(size_t)unit * 128 + 2 * dp] = run0 + suf0; DC[(size_t)unit * 128 + 2 * dp + 1] = run1 + suf1; }
        { float a[8], bb[8];
#pragma unroll
          for (int u = 0; u < 8; ++u) { a[u] = k0[u] * ex2(suf0 + run0 - c0[u]); bb[u] = k1[u] * ex2(suf1 + run1 - c1[u]); }
          v4u o; o.x = pk2(a[0], a[1]); o.y = pk2(a[2], a[3]); o.z = pk2(a[4], a[5]); o.w = pk2(a[6], a[7]); *(v4u*)(Kh + (2 * dp) * VS + 16 * hs) = o;
          o.x = pk2(bb[0], bb[1]); o.y = pk2(bb[2], bb[3]); o.z = pk2(bb[4], bb[5]); o.w = pk2(bb[6], bb[7]); *(v4u*)(Kh + (2 * dp + 1) * VS + 16 * hs) = o; }
        __syncthreads();
        pg8::f32x4 acc[8];
#pragma unroll
        for (int ne = 0; ne < 8; ++ne) acc[ne] = (pg8::f32x4){0.f, 0.f, 0.f, 0.f};
#pragma unroll
        for (int ks = 0; ks < 2; ++ks) { const pg8::bf16x8 a = *(const pg8::bf16x8*)(Kh + (16 * hs + l15) * VS + 64 * ks + 16 * q4);
#pragma unroll
            for (int ne = 0; ne < 8; ++ne) { const pg8::bf16x8 bfr = *(const pg8::bf16x8*)(Vt + (16 * ne + l15) * VS + 64 * ks + 16 * q4);
                acc[ne] = __builtin_amdgcn_mfma_f32_16x16x32_bf16(a, bfr, acc[ne], 0, 0, 0); } }
#pragma unroll
        for (int ne = 0; ne < 8; ++ne) { v2u wv; wv.x = pk2(acc[ne][0], acc[ne][1]); wv.y = pk2(acc[ne][2], acc[ne][3]);
            *(v2u*)(ST + ((size_t)unit * 128 + 16 * ne + l15) * 128 + 16 * hs + 4 * q4) = wv; }
    }
#undef HA_LOAD
}
__device__ __forceinline__ void hgrn_pass_b(const Params& p, bool dry) {
    int tid = threadIdx.x; asm volatile("" : "+v"(tid));
    unsigned* ST = (unsigned*)(p.ws + WS_ST); const float* DC = (const float*)(p.ws + WS_DC);
    for (int gid = blockIdx.x * 512 + tid; gid < 16 * 128 * 64; gid += gridDim.x * 512) {
        const int bh = gid >> 13, rem = gid & 8191, d2 = rem & 63;
        unsigned* sp = ST + (size_t)bh * NCHUNK * 8192 + rem; const float* dp = DC + (size_t)bh * NCHUNK * 128 + 2 * d2;
        float s0 = 0.f, s1 = 0.f;
        for (int c0 = 0; c0 < NCHUNK; c0 += 8) { unsigned w[8]; v2u dc[8];
#pragma unroll
            for (int j = 0; j < 8; ++j) { w[j] = __builtin_nontemporal_load(sp + (size_t)(c0 + j) * 8192); dc[j] = *(const v2u*)(dp + (c0 + j) * 128); }
#pragma unroll
            for (int j = 0; j < 8; ++j) { if (!dry || s0 == 1.2345e30f) sp[(size_t)(c0 + j) * 8192] = pk2(s0, s1); s0 = ex2(__uint_as_float(dc[j].x)) * s0 + bf2f(w[j] & 0xffffu); s1 = ex2(__uint_as_float(dc[j].y)) * s1 + bf2f(w[j] >> 16); } }
    }
}
__device__ __forceinline__ void hgrn_pass_c(const Params& p, unsigned char* lds, bool dry) {
    int tid = threadIdx.x; asm volatile("" : "+v"(tid));
    const int lane = tid & 63, hs = __builtin_amdgcn_readfirstlane(tid >> 6), dp = lane, l15 = lane & 15, q4 = lane >> 4;
    unsigned char* ws = p.ws;
    unsigned char* Qt = lds + C_QT; unsigned char* Qp = lds + C_QP; unsigned char* Kt = lds + C_KT; unsigned char* Vt = lds + C_VT; unsigned char* St = lds + C_ST;
    float* tot = (float*)(lds + C_TOT); float* part = (float*)(lds + C_PART);
    const bf16* LF = (const bf16*)(ws + WS_LF); const bf16* VH = (const bf16*)(ws + WS_VH); const bf16* QH = (const bf16*)(ws + WS_QH); const bf16* GH = (const bf16*)(ws + WS_GH);
    const bf16* ST = (const bf16*)(ws + WS_ST); bf16* OG = (bf16*)(ws + WS_QH); const float* ogain = p.in[6];
    const int ti = hs & 3, eh = hs >> 2;
    f32x4 gnv[4];
#pragma unroll
    for (int me = 0; me < 4; ++me) gnv[me] = *(const f32x4*)(ogain + 64 * eh + 16 * me + 4 * q4);
    unsigned rlf[8]; unsigned rq[8]; v4u rve, rvo, rst[4]; v2u rgh[4];
#define HC_LOAD(U) do { const int bh_ = (U) / NCHUNK, c_ = (U) % NCHUNK; const size_t r0_ = (size_t)(bh_ >> 3) * SEQ + (size_t)c_ * 64; const int h_ = bh_ & 7; \
        _Pragma("unroll") for (int u = 0; u < 8; ++u) { const size_t go_ = (r0_ + 8 * hs + u) * DM + h_ * 128 + 2 * dp; rlf[u] = *(const unsigned*)(LF + go_); rq[u] = __builtin_nontemporal_load((const unsigned*)(QH + go_)); } \
        const size_t vo_ = (r0_ + 2 * (tid & 31)) * DM + h_ * 128 + (tid >> 5) * 8; rve = *(const v4u*)(VH + vo_); rvo = *(const v4u*)(VH + vo_ + DM); \
        _Pragma("unroll") for (int it = 0; it < 4; ++it) { const int idx_ = tid + 512 * it; rst[it] = __builtin_nontemporal_load((const v4u*)(ST + ((size_t)(U) * 128 + (idx_ >> 4)) * 128 + (idx_ & 15) * 8)); } \
        _Pragma("unroll") for (int me = 0; me < 4; ++me) rgh[me] = __builtin_nontemporal_load((const v2u*)(GH + (r0_ + 16 * ti + l15) * DM + h_ * 128 + 64 * eh + 16 * me + 4 * q4)); } while (0)
    if ((int)blockIdx.x < 16 * NCHUNK) HC_LOAD(HG_UNIT((int)blockIdx.x));
    for (int li = blockIdx.x; li < 16 * NCHUNK; li += gridDim.x) { const int unit = HG_UNIT(li);
        const int bh = unit / NCHUNK, c = unit % NCHUNK, b = bh >> 3, h = bh & 7; const size_t row0 = (size_t)b * SEQ + (size_t)c * 64;
        __syncthreads();
        hgrn_stage_vt(Vt, rve, rvo, tid);
#pragma unroll
        for (int it = 0; it < 4; ++it) { const int idx = tid + 512 * it, e = idx >> 4, c16 = idx & 15; *(v4u*)(St + e * RS + c16 * 16) = rst[it]; }
        float c0[8], c1[8], k0[8], k1[8], qa[8], qb[8]; float run0 = 0.f, run1 = 0.f;
#pragma unroll
        for (int u = 0; u < 8; ++u) { const float x0 = bf2f(rlf[u] & 0xffffu), x1 = bf2f(rlf[u] >> 16);
            qa[u] = bf2f(rq[u] & 0xffffu); qb[u] = bf2f(rq[u] >> 16);
            k0[u] = 1.0f - ex2(x0); k1[u] = 1.0f - ex2(x1); run0 += x0; run1 += x1; c0[u] = run0; c1[u] = run1; }
        v2u gh[4];
#pragma unroll
        for (int me = 0; me < 4; ++me) gh[me] = rgh[me];
        tot[hs * 128 + 2 * dp] = run0; tot[hs * 128 + 2 * dp + 1] = run1;
        if (li + (int)gridDim.x < 16 * NCHUNK) HC_LOAD(HG_UNIT(li + (int)gridDim.x));
        __syncthreads();
        {
          float base0 = 0.f, base1 = 0.f, R0[4], R1[4]; float p0 = 0.f, p1 = 0.f;
#pragma unroll
          for (int hh = 0; hh < 8; ++hh) { if ((hh & 1) == 0) { R0[hh >> 1] = p0; R1[hh >> 1] = p1; } if (hh == hs) { base0 = p0; base1 = p1; }
              p0 += tot[hh * 128 + 2 * dp]; p1 += tot[hh * 128 + 2 * dp + 1]; }
          const int i = hs >> 1;
          const float Ri0 = i == 0 ? R0[0] : (i == 1 ? R0[1] : (i == 2 ? R0[2] : R0[3])), Ri1 = i == 0 ? R1[0] : (i == 1 ? R1[1] : (i == 2 ? R1[2] : R1[3]));
#pragma unroll
          for (int u = 0; u < 8; ++u) { const int t = 8 * hs + u; const float cu0 = base0 + c0[u], cu1 = base1 + c1[u];
              *(unsigned*)(Qp + t * RS + 4 * dp) = pk2(qa[u] * ex2(cu0), qb[u] * ex2(cu1));
              *(unsigned*)(Qt + t * RS + 4 * dp) = pk2(qa[u] * ex2(cu0 - Ri0), qb[u] * ex2(cu1 - Ri1));
#pragma unroll
              for (int ip = 0; ip < 4; ++ip) if (ip >= i) *(unsigned*)(Kt + (8 * ip * (ip + 1) + t) * RS + 4 * dp) = pk2(k0[u] * ex2(R0[ip] - cu0), k1[u] * ex2(R1[ip] - cu1)); } }
        __syncthreads();
        pg8::f32x4 sct[4]; pg8::bf16x8 qf[4];
#pragma unroll
        for (int ks = 0; ks < 4; ++ks) qf[ks] = *(const pg8::bf16x8*)(Qt + (16 * ti + l15) * RS + 64 * ks + 16 * q4);
#pragma unroll
        for (int j = 0; j < 4; ++j) { sct[j] = (pg8::f32x4){0.f, 0.f, 0.f, 0.f};
            if (j <= ti) { const unsigned char* kr = Kt + (8 * ti * (ti + 1) + 16 * j + l15) * RS + 16 * q4;
#pragma unroll
                for (int ks = 0; ks < 4; ++ks) sct[j] = __builtin_amdgcn_mfma_f32_16x16x32_bf16(*(const pg8::bf16x8*)(kr + 64 * ks), qf[ks], sct[j], 0, 0, 0);
                if (j == ti) {
#pragma unroll
                    for (int r = 0; r < 4; ++r) if (4 * q4 + r > l15) sct[j][r] = 0.f; } } }
        pg8::f32x4 o[4];
#pragma unroll
        for (int me = 0; me < 4; ++me) o[me] = (pg8::f32x4){0.f, 0.f, 0.f, 0.f};
#pragma unroll
        for (int pp = 0; pp < 2; ++pp) if (2 * pp <= ti) {
            v4u pw; pw.x = pk2(sct[2 * pp][0], sct[2 * pp][1]); pw.y = pk2(sct[2 * pp][2], sct[2 * pp][3]); pw.z = pk2(sct[2 * pp + 1][0], sct[2 * pp + 1][1]); pw.w = pk2(sct[2 * pp + 1][2], sct[2 * pp + 1][3]);
            const pg8::bf16x8 bfr = __builtin_bit_cast(pg8::bf16x8, pw);
#pragma unroll
            for (int me = 0; me < 4; ++me) { const unsigned char* vr = Vt + (64 * eh + 16 * me + l15) * VS + (32 * pp + 4 * q4) * 2;
                const v2u lo = *(const v2u*)vr, hi = *(const v2u*)(vr + 32); v4u aw; aw.x = lo.x; aw.y = lo.y; aw.z = hi.x; aw.w = hi.y;
                o[me] = __builtin_amdgcn_mfma_f32_16x16x32_bf16(__builtin_bit_cast(pg8::bf16x8, aw), bfr, o[me], 0, 0, 0); } }
#pragma unroll
        for (int ks = 0; ks < 4; ++ks) { const pg8::bf16x8 bq = *(const pg8::bf16x8*)(Qp + (16 * ti + l15) * RS + 64 * ks + 16 * q4);
#pragma unroll
            for (int me = 0; me < 4; ++me) o[me] = __builtin_amdgcn_mfma_f32_16x16x32_bf16(*(const pg8::bf16x8*)(St + (64 * eh + 16 * me + l15) * RS + 64 * ks + 16 * q4), bq, o[me], 0, 0, 0); }
        float ss = 0.f;
#pragma unroll
        for (int me = 0; me < 4; ++me) ss += (o[me][0] * o[me][0] + o[me][1] * o[me][1]) + (o[me][2] * o[me][2] + o[me][3] * o[me][3]);
        ss += __shfl_xor(ss, 16); ss += __shfl_xor(ss, 32);
        if (q4 == 0) part[hs * 16 + l15] = ss;
        __syncthreads();
        ss += part[(hs ^ 4) * 16 + l15];
        const float rstd = rsqrtf(ss * (1.0f / 128.0f) + EPS);
#pragma unroll
        for (int me = 0; me < 4; ++me) { const int e0 = 64 * eh + 16 * me + 4 * q4; const size_t off = (row0 + 16 * ti + l15) * DM + h * 128 + e0;
            const f32x4 gn = gnv[me]; const v2u gw = gh[me];
            v2u wv; wv.x = pk2(o[me][0] * rstd * gn.x * bf2f(gw.x & 0xffffu), o[me][1] * rstd * gn.y * bf2f(gw.x >> 16));
            wv.y = pk2(o[me][2] * rstd * gn.z * bf2f(gw.y & 0xffffu), o[me][3] * rstd * gn.w * bf2f(gw.y >> 16));
            if (!dry || ss < 0.f) *(v2u*)(OG + off) = wv; }
    }
#undef HC_LOAD
}

constexpr int KB_STRIDE = 144, VT_STRIDE = 528, ATT_VT_OFF = 256 * KB_STRIDE, ATT_BIAS_OFF = ATT_VT_OFF + 64 * VT_STRIDE;
__device__ __forceinline__ void unpack8(const v4u w, float* f) {
    f[0] = bf2f(w.x & 0xffffu); f[1] = bf2f(w.x >> 16); f[2] = bf2f(w.y & 0xffffu); f[3] = bf2f(w.y >> 16);
    f[4] = bf2f(w.z & 0xffffu); f[5] = bf2f(w.z >> 16); f[6] = bf2f(w.w & 0xffffu); f[7] = bf2f(w.w >> 16);
}
struct AttnRaw { v4u kw[4]; v4u ve[2], vo[2]; v4u qa, qb; v2u oo[4]; float lold; float bias; };
__device__ __forceinline__ void attn_unit_coords(int unit, int nqb, int dl, int& b, int& h, int& r, int& i0) {
    const int bh = unit >> 7, xq = unit & 127; b = bh >> 4; h = bh & 15; r = xq / nqb; i0 = (xq % nqb) * 128;
}
__device__ __forceinline__ void attn_load(AttnRaw& R, int unit, int g, int dl, int nqb, const bf16* QG, const bf16* KG, const bf16* VG, const bf16* OACC, const float* LSE, const float* relb_g, int tid, int w, int l15, int q4) {
    int b, h, r, i0; attn_unit_coords(unit, nqb, dl, b, h, r, i0); const size_t rowb = (size_t)b * SEQ;
    const size_t hb = ((size_t)(b * 16 + h) << 14) + (size_t)r * (SEQ / dl);
#pragma unroll
    for (int it = 0; it < 4; ++it) { const int idx = tid + 512 * it, jl = idx >> 3, c8 = idx & 7; const int jj = i0 - 128 + jl;
        R.kw[it] = (v4u){0u, 0u, 0u, 0u};
        if (jj >= 0) R.kw[it] = *(const v4u*)(KG + (hb + jj) * 64 + c8 * 8); }
#pragma unroll
    for (int it = 0; it < 2; ++it) { const int idx = tid + 512 * it, kp = idx & 127, c8 = idx >> 7; const int jj = i0 - 128 + 2 * kp;
        R.ve[it] = (v4u){0u, 0u, 0u, 0u}; R.vo[it] = (v4u){0u, 0u, 0u, 0u};
        if (jj >= 0) { const size_t off = (hb + jj) * 64 + c8 * 8; R.ve[it] = *(const v4u*)(VG + off); R.vo[it] = *(const v4u*)(VG + off + 64); } }
    const size_t qrow = rowb + r + (size_t)dl * (i0 + 16 * w + l15);
    const size_t qoff = (hb + i0 + 16 * w + l15) * 64;
    R.qa = __builtin_nontemporal_load((const v4u*)(QG + qoff + 8 * q4)); R.qb = __builtin_nontemporal_load((const v4u*)(QG + qoff + 32 + 8 * q4));
    R.lold = 0.f; R.bias = tid < 129 ? relb_g[h] : 0.f;
#pragma unroll
    for (int md = 0; md < 4; ++md) R.oo[md] = (v2u){0u, 0u};
    if (g > 0) { R.lold = LSE[qrow * 16 + h];
#pragma unroll
        for (int md = 0; md < 4; ++md) R.oo[md] = __builtin_nontemporal_load((const v2u*)(OACC + qrow * DM + h * 64 + 4 * q4 + 16 * md)); }
}
__device__ __forceinline__ void attn_group(const Params& p, unsigned char* lds, int g) {
    int tid = threadIdx.x; asm volatile("" : "+v"(tid));
    const int lane = tid & 63, w = __builtin_amdgcn_readfirstlane(tid >> 6), l15 = lane & 15, q4 = lane >> 4;
    unsigned char* ws = p.ws;
    unsigned char* Kb = lds; unsigned char* Vt = lds + ATT_VT_OFF; float* bias = (float*)(lds + ATT_BIAS_OFF);
    const bf16* QG = (const bf16*)(ws + WS_QG); const bf16* KG = (const bf16*)(ws + WS_KG); const bf16* VG = (const bf16*)(ws + WS_VG);
    bf16* OACC = (bf16*)(ws + WS_QH); float* LSE = (float*)(ws + WS_LSE);
    const float* kgain = p.in[10] + g * 64; const float* qgain = p.in[12] + g * 64; const float* relb = p.in[14];
    const int dl = g == 0 ? 1 : (g == 1 ? 4 : 16), nqb = 128 / dl;
    const int G = gridDim.x, bx = blockIdx.x; const int vcu = (G % 8 == 0) ? (bx % 8) * (G / 8) + bx / 8 : bx;
    const float* relb_g = relb + (int)T5_BUCKET[g][tid < 129 ? tid : 0] * 48 + g * 16;
    const int c8k = tid & 7;
    const f32x4 kg0 = *(const f32x4*)(kgain + c8k * 8), kg1 = *(const f32x4*)(kgain + c8k * 8 + 4);
    const f32x4 ga0 = *(const f32x4*)(qgain + 8 * q4), ga1 = *(const f32x4*)(qgain + 8 * q4 + 4), gb0 = *(const f32x4*)(qgain + 32 + 8 * q4), gb1 = *(const f32x4*)(qgain + 32 + 8 * q4 + 4);
    AttnRaw R;
    if (vcu < 2 * 16 * 128) attn_load(R, vcu, g, dl, nqb, QG, KG, VG, OACC, LSE, relb_g, tid, w, l15, q4);
    for (int unit = vcu; unit < 2 * 16 * 128; unit += G) {
        int b, h, r, i0; attn_unit_coords(unit, nqb, dl, b, h, r, i0);
        const size_t rowb = (size_t)b * SEQ;
        __syncthreads();
        if (tid < 129) bias[tid] = R.bias * LOG2E;
#pragma unroll
        for (int it = 0; it < 4; ++it) { const int idx = tid + 512 * it, jl = idx >> 3, c8 = idx & 7;
            float kf[8]; unpack8(R.kw[it], kf);
            float ss = 0.f;
#pragma unroll
            for (int e = 0; e < 8; ++e) ss += kf[e] * kf[e];
            ss += __shfl_xor(ss, 1); ss += __shfl_xor(ss, 2); ss += __shfl_xor(ss, 4);
            const float rstd = rsqrtf(ss * (1.0f / 64.0f) + EPS);
            v4u o; o.x = pk2(kf[0] * rstd * kg0.x, kf[1] * rstd * kg0.y); o.y = pk2(kf[2] * rstd * kg0.z, kf[3] * rstd * kg0.w);
            o.z = pk2(kf[4] * rstd * kg1.x, kf[5] * rstd * kg1.y); o.w = pk2(kf[6] * rstd * kg1.z, kf[7] * rstd * kg1.w);
            *(v4u*)(Kb + jl * KB_STRIDE + c8 * 16) = o; }
#pragma unroll
        for (int it = 0; it < 2; ++it) { const int idx = tid + 512 * it, kp = idx & 127, c8 = idx >> 7; const v4u we = R.ve[it], wo = R.vo[it];
            unsigned char* vd = Vt + (8 * c8) * VT_STRIDE + 4 * kp;
            *(unsigned*)(vd + 0 * VT_STRIDE) = (we.x & 0xffffu) | (wo.x << 16); *(unsigned*)(vd + 1 * VT_STRIDE) = (we.x >> 16) | (wo.x & 0xffff0000u);
            *(unsigned*)(vd + 2 * VT_STRIDE) = (we.y & 0xffffu) | (wo.y << 16); *(unsigned*)(vd + 3 * VT_STRIDE) = (we.y >> 16) | (wo.y & 0xffff0000u);
            *(unsigned*)(vd + 4 * VT_STRIDE) = (we.z & 0xffffu) | (wo.z << 16); *(unsigned*)(vd + 5 * VT_STRIDE) = (we.z >> 16) | (wo.z & 0xffff0000u);
            *(unsigned*)(vd + 6 * VT_STRIDE) = (we.w & 0xffffu) | (wo.w << 16); *(unsigned*)(vd + 7 * VT_STRIDE) = (we.w >> 16) | (wo.w & 0xffff0000u); }
        const size_t qrow = rowb + r + (size_t)dl * (i0 + 16 * w + l15);
        pg8::bf16x8 qf0, qf1;
        { float qa[8], qb_[8]; unpack8(R.qa, qa); unpack8(R.qb, qb_);
          float ss = 0.f;
#pragma unroll
          for (int e = 0; e < 8; ++e) ss += qa[e] * qa[e] + qb_[e] * qb_[e];
          ss += __shfl_xor(ss, 16); ss += __shfl_xor(ss, 32);
          const float rstd = rsqrtf(ss * (1.0f / 64.0f) + EPS) * 0.125f * LOG2E;
          v4u o; o.x = pk2(qa[0] * rstd * ga0.x, qa[1] * rstd * ga0.y); o.y = pk2(qa[2] * rstd * ga0.z, qa[3] * rstd * ga0.w); o.z = pk2(qa[4] * rstd * ga1.x, qa[5] * rstd * ga1.y); o.w = pk2(qa[6] * rstd * ga1.z, qa[7] * rstd * ga1.w);
          qf0 = __builtin_bit_cast(pg8::bf16x8, o);
          o.x = pk2(qb_[0] * rstd * gb0.x, qb_[1] * rstd * gb0.y); o.y = pk2(qb_[2] * rstd * gb0.z, qb_[3] * rstd * gb0.w); o.z = pk2(qb_[4] * rstd * gb1.x, qb_[5] * rstd * gb1.y); o.w = pk2(qb_[6] * rstd * gb1.z, qb_[7] * rstd * gb1.w);
          qf1 = __builtin_bit_cast(pg8::bf16x8, o); }
        v2u oo[4]; const float lold = R.lold;
#pragma unroll
        for (int md = 0; md < 4; ++md) oo[md] = R.oo[md];
        if (unit + G < 2 * 16 * 128) attn_load(R, unit + G, g, dl, nqb, QG, KG, VG, OACC, LSE, relb_g, tid, w, l15, q4);
        __syncthreads();
        pg8::f32x4 s[9];
#pragma unroll
        for (int kt = 0; kt < 9; ++kt) { const unsigned char* kr = Kb + (16 * (w + kt) + l15) * KB_STRIDE + 16 * q4;
            const pg8::bf16x8 a0 = *(const pg8::bf16x8*)kr, a1 = *(const pg8::bf16x8*)(kr + 64);
            pg8::f32x4 z = (pg8::f32x4){0.f, 0.f, 0.f, 0.f};
            z = __builtin_amdgcn_mfma_f32_16x16x32_bf16(a0, qf0, z, 0, 0, 0);
            s[kt] = __builtin_amdgcn_mfma_f32_16x16x32_bf16(a1, qf1, z, 0, 0, 0); }
        float m = -INFINITY;
        if (i0 == 0) {
#pragma unroll
            for (int kt = 0; kt < 9; ++kt)
#pragma unroll
                for (int rr = 0; rr < 4; ++rr) { const int dlt = 128 - 16 * kt - 4 * q4 - rr + l15; const int jl = 16 * (w + kt) + 4 * q4 + rr;
                    const bool valid = dlt >= 0 && dlt <= 128 && jl >= 128;
                    const int dc = dlt < 0 ? 0 : (dlt > 128 ? 128 : dlt);
                    const float v = valid ? s[kt][rr] + bias[dc] : -INFINITY; s[kt][rr] = v; m = fmaxf(m, v); }
        } else {
            const int d0 = 128 - 4 * q4 + l15;
#pragma unroll
            for (int rr = 0; rr < 4; ++rr) { const int dlt = d0 - rr; const float v = dlt <= 128 ? s[0][rr] + bias[dlt > 128 ? 128 : dlt] : -INFINITY; s[0][rr] = v; m = fmaxf(m, v); }
#pragma unroll
            for (int kt = 1; kt < 8; ++kt)
#pragma unroll
                for (int rr = 0; rr < 4; ++rr) { const float v = s[kt][rr] + bias[d0 - 16 * kt - rr]; s[kt][rr] = v; m = fmaxf(m, v); }
#pragma unroll
            for (int rr = 0; rr < 4; ++rr) { const int dlt = d0 - 128 - rr; const float v = dlt >= 0 ? s[8][rr] + bias[dlt < 0 ? 0 : dlt] : -INFINITY; s[8][rr] = v; m = fmaxf(m, v); }
        }
        m = fmaxf(m, __shfl_xor(m, 16)); m = fmaxf(m, __shfl_xor(m, 32));
        float l = 0.f;
#pragma unroll
        for (int kt = 0; kt < 9; ++kt)
#pragma unroll
            for (int rr = 0; rr < 4; ++rr) { const float pr = ex2(s[kt][rr] - m); s[kt][rr] = pr; l += pr; }
        l += __shfl_xor(l, 16); l += __shfl_xor(l, 32);
        pg8::f32x4 o[4];
#pragma unroll
        for (int md = 0; md < 4; ++md) o[md] = (pg8::f32x4){0.f, 0.f, 0.f, 0.f};
#pragma unroll
        for (int pi = 0; pi < 5; ++pi) {
            v4u pw; pw.x = pk2(s[2 * pi][0], s[2 * pi][1]); pw.y = pk2(s[2 * pi][2], s[2 * pi][3]);
            if (pi < 4) { pw.z = pk2(s[2 * pi + 1][0], s[2 * pi + 1][1]); pw.w = pk2(s[2 * pi + 1][2], s[2 * pi + 1][3]); } else { pw.z = 0u; pw.w = 0u; }
            const pg8::bf16x8 bfr = __builtin_bit_cast(pg8::bf16x8, pw);
#pragma unroll
            for (int md = 0; md < 4; ++md) { const unsigned char* vr = Vt + (16 * md + l15) * VT_STRIDE + (16 * (w + 2 * pi) + 4 * q4) * 2;
                const v2u lo = *(const v2u*)vr; v2u hi = (v2u){0u, 0u}; if (pi < 4) hi = *(const v2u*)(vr + 32);
                v4u aw; aw.x = lo.x; aw.y = lo.y; aw.z = hi.x; aw.w = hi.y;
                o[md] = __builtin_amdgcn_mfma_f32_16x16x32_bf16(__builtin_bit_cast(pg8::bf16x8, aw), bfr, o[md], 0, 0, 0); } }
        const float inv = 1.0f / l; float lse2 = m + __log2f(l);
        bf16* op = OACC + qrow * DM + h * 64 + 4 * q4; float* lp = LSE + qrow * 16 + h;
        float a = 0.f, bq = inv;
        if (g > 0) { const float mx = fmaxf(lold, lse2); const float wo_ = ex2(lold - mx), wn = ex2(lse2 - mx); const float den = wo_ + wn; a = wo_ / den; bq = inv * wn / den; lse2 = mx + __log2f(den); }
#pragma unroll
        for (int md = 0; md < 4; ++md) { float v0 = o[md][0] * bq, v1 = o[md][1] * bq, v2 = o[md][2] * bq, v3 = o[md][3] * bq;
            if (g > 0) { const v2u ow = oo[md]; v0 += a * bf2f(ow.x & 0xffffu); v1 += a * bf2f(ow.x >> 16); v2 += a * bf2f(ow.y & 0xffffu); v3 += a * bf2f(ow.y >> 16); }
            v2u wv; wv.x = pk2(v0, v1); wv.y = pk2(v2, v3);
            if (g < 2) __builtin_nontemporal_store(wv, (v2u*)(op + 16 * md)); else *(v2u*)(op + 16 * md) = wv; }
        if (q4 == 0 && g < 2) *lp = lse2;
    }
}

#define XB_TMO      128
#define XB_XCNT(j)  (256  + 64 * (j))
#define XB_XSUB(j)  (1280 + 64 * (j))
#define XB_XGEN(j)  (2304 + 64 * (j))
#define XB_TOP      3328
#define XB_TOPGEN   3392
#define XCD_BAR_WORDS 3456
#define XB_SPIN_CAP (1u << 18)

__device__ __forceinline__ unsigned xb_ld(unsigned* p)              { return __hip_atomic_load(p, __ATOMIC_RELAXED, __HIP_MEMORY_SCOPE_AGENT); }
__device__ __forceinline__ unsigned xb_add(unsigned* p, unsigned v) { return __hip_atomic_fetch_add(p, v, __ATOMIC_RELAXED, __HIP_MEMORY_SCOPE_AGENT); }
__device__ __forceinline__ unsigned xb_xcc_id() { return (unsigned)__builtin_amdgcn_s_getreg((3 << 11) | 20) & 0xFu; }
#define XB_SPIN(cond, bar) do { unsigned _sp = 0; while (cond) { __builtin_amdgcn_s_sleep(1); \
    if ((++_sp & 255u) == 0u) { if (xb_ld(&(bar)[XB_TMO])) break; if (_sp > XB_SPIN_CAP) { atomicAdd(&(bar)[XB_TMO], 1u); break; } } } } while (0)

struct XcdBarrier {
    unsigned* bar; unsigned x;
    volatile LAS unsigned* st;
};

__device__ __forceinline__ XcdBarrier xcd_barrier_post(unsigned* bar, volatile LAS unsigned* st) {
    XcdBarrier b; b.bar = bar; b.x = xb_xcc_id(); b.st = st;
    if (threadIdx.x == 0) (void)xb_add(&bar[XB_XCNT(b.x)], 1u);
    return b;
}
__device__ __forceinline__ void xcd_barrier_complete(unsigned* bar, unsigned x, unsigned& nloc, unsigned& nx) {
    const unsigned G = gridDim.x * gridDim.y * gridDim.z;
    unsigned sum, cnt, mine, sp = 0u;
    for (;;) {
        sum = 0u; cnt = 0u; mine = 0u;
#pragma unroll
        for (unsigned j = 0; j < 16; ++j) { const unsigned c = xb_ld(&bar[XB_XCNT(j)]); sum += c; cnt += (c > 0u) ? 1u : 0u; mine = (j == x) ? c : mine; }
        if (sum == G) break;
        __builtin_amdgcn_s_sleep(1);
        if ((++sp & 255u) == 0u) { if (xb_ld(&bar[XB_TMO])) break; if (sp > XB_SPIN_CAP) { atomicAdd(&bar[XB_TMO], 1u); break; } }
    }
    nloc = mine > 0u ? mine : 1u; nx = cnt > 0u ? cnt : 1u;
}

__device__ __forceinline__ void xcd_barrier(const XcdBarrier& b) {
    asm volatile("s_waitcnt vmcnt(0)" ::: "memory");
    __syncthreads();
    if (threadIdx.x == 0) {
        unsigned* bar = b.bar;
        __builtin_amdgcn_s_waitcnt(0);
        unsigned nloc = b.st[0], nx = b.st[1];
        if (nloc == 0u) { xcd_barrier_complete(bar, b.x, nloc, nx); b.st[0] = nloc; b.st[1] = nx; }
        const unsigned old = xb_add(&bar[XB_XSUB(b.x)], 1u);
        const unsigned gen = old / nloc;
        if (old + 1u == (gen + 1u) * nloc) {
            __builtin_amdgcn_fence(__ATOMIC_RELEASE, "agent");
            asm volatile("s_waitcnt vmcnt(0)" ::: "memory");
            const unsigned og = xb_add(&bar[XB_TOP], 1u);
            const unsigned tg = og / nx;
            if (og + 1u == (tg + 1u) * nx) xb_add(&bar[XB_TOPGEN], 1u);
            else XB_SPIN(xb_ld(&bar[XB_TOPGEN]) == tg, bar);
            __builtin_amdgcn_fence(__ATOMIC_ACQUIRE, "agent");
            xb_add(&bar[XB_XGEN(b.x)], 1u);
            asm volatile("s_waitcnt vmcnt(0)" ::: "memory");
        } else {
            XB_SPIN(xb_ld(&bar[XB_XGEN(b.x)]) == gen, bar);
            __builtin_amdgcn_fence(__ATOMIC_ACQUIRE, "agent");
            asm volatile("s_waitcnt vmcnt(0)" ::: "memory");
        }
    }
    __syncthreads();
}

struct GridBarFn { static __device__ __forceinline__ void sync(unsigned* w, unsigned st) { XcdBarrier xb; xb.bar = w; xb.x = xb_xcc_id(); xb.st = (volatile LAS unsigned*)(size_t)st; xcd_barrier(xb); } };
template <class Epi> __device__ __forceinline__ void run_gemm(unsigned char* lds, const bf16* A, const bf16* Bt, int N, int K, const Epi& E) {
    pg8::Gemm g{A, Bt, MTOK, N, K}; pg8::StaticOrder S; S.init(MTOK, N, (int)gridDim.x, (int)blockIdx.x);
    pg8::gemm_phase<Epi, pg8::StaticOrder, true, true>((LAS unsigned char*)lds, g, S, E);
}
enum { T_CONV0 = 0, T_FFN_IN, T_RESID, T_RMS, T_AIN, T_HA, T_HB, T_HC, T_QKV, T_ATT };
constexpr int NPH = 21;
__device__ __forceinline__ void phase_desc(int ph, int& type, int& arg) {
    switch (ph) {
        case 0: type = T_CONV0; arg = 0; break;
        case 1: type = T_FFN_IN; arg = 0; break;   case 2: type = T_RESID; arg = 0; break;
        case 3: type = T_AIN; arg = 0; break;      case 4: type = T_HA; arg = 0; break;   case 5: type = T_HB; arg = 0; break;   case 6: type = T_HC; arg = 0; break;
        case 7: type = T_RESID; arg = 4; break;
        case 8: type = T_FFN_IN; arg = 1; break;   case 9: type = T_RESID; arg = 1; break;
        case 10: type = T_FFN_IN; arg = 2; break;  case 11: type = T_RESID; arg = 2; break;
        case 12: type = T_QKV; arg = 0; break;     case 13: type = T_ATT; arg = 0; break;
        case 14: type = T_QKV; arg = 1; break;     case 15: type = T_ATT; arg = 1; break;
        case 16: type = T_QKV; arg = 2; break;     case 17: type = T_ATT; arg = 2; break;
        case 18: type = T_RESID; arg = 5; break;
        case 19: type = T_FFN_IN; arg = 3; break;  default: type = T_RESID; arg = 3; break;
    }
}
__global__ void __launch_bounds__(512) yoco_fwd(Params p0) {
    extern __shared__ __attribute__((aligned(16))) unsigned char lds[];
    cg::grid_group grid = cg::this_grid();
    volatile LAS unsigned* bst = (volatile LAS unsigned*)((LAS unsigned char*)lds + (LDS_BYTES - 16));
    if (threadIdx.x == 0) { bst[0] = 0u; bst[1] = 0u; }
    __syncthreads();
    (void)xcd_barrier_post((unsigned*)(p0.ws + WS_BAR), bst);
    const int ph_hi = p0.ph_hi;
    for (int ph = p0.ph_lo; ph < ph_hi; ++ph) {
        int rph = ph; bool dry = false;
#ifdef PROBE_PH
        if (ph == PROBE_PH) dry = true;
        if (ph > PROBE_PH) rph = ph - 1;
#endif
        int type, arg; phase_desc(rph, type, arg);
        const __attribute__((address_space(4))) Params* pp = (const __attribute__((address_space(4))) Params*)__builtin_amdgcn_kernarg_segment_ptr();
        asm volatile("" : "+s"(pp));
        Params p;
#pragma unroll
        for (int i = 0; i < 15; ++i) p.in[i] = pp->in[i];
        p.out = pp->out; p.ws = pp->ws; p.ph_lo = 0; p.ph_hi = 0;
        int tid = threadIdx.x; asm volatile("" : "+v"(tid));
        const int lane = tid & 63, wave = __builtin_amdgcn_readfirstlane(tid >> 6);
        const int gw = blockIdx.x * 8 + wave, ngw = gridDim.x * 8;
        unsigned char* ws = p.ws;
        bf16* XN = (bf16*)(ws + WS_XN); bf16* XN3 = (bf16*)(ws + WS_XN3); bf16* HB = (bf16*)(ws + WS_H);
        if (type == T_CONV0) {
#ifndef SK_CONV
            convert_layer0(p, lds, gw, ngw, wave, lane);
#endif
#ifndef SK_RMS
            rms_rows(p.in[0], p.in[1], XN, nullptr, nullptr, gw, ngw, lane);
#endif
        } else if (type == T_RMS) {
#ifndef SK_RMS
            if (arg == 3) rms_rows(p.out, p.in[8], XN3, p.in[1] + 3 * DM, XN, gw, ngw, lane);
            else rms_rows(p.out, p.in[1] + arg * DM, XN, nullptr, nullptr, gw, ngw, lane);
#endif
        } else if (type == T_FFN_IN) {
            const size_t wo = arg == 0 ? WS_WIN0 : (arg == 1 ? WS_WIN1 : (arg == 2 ? WS_WIN2 : WS_WIN3));
            pg8::EpiSwiglu E{HB};
#ifndef SK_G1
            run_gemm(lds, XN, (const bf16*)(ws + wo), 2 * DFF, DM, E);
#endif
        } else if (type == T_RESID) {
            const bf16* A; const bf16* Bt; int K; const float* res = p.out; float scale = 0.5f;
            if (arg < 4) { A = HB; K = DFF; Bt = (const bf16*)(ws + (arg == 0 ? WS_WOUT0 : (arg == 1 ? WS_WOUT1 : (arg == 2 ? WS_WOUT2 : WS_WOUT3)))); if (arg == 0) res = p.in[0]; }
            else if (arg == 4) { A = (const bf16*)(ws + WS_QH); K = DM; Bt = (const bf16*)(ws + WS_WAOUT); scale = 1.0f;
#ifndef SK_CONV
            if (!dry) { convert_layer1(p, lds, gw, ngw, wave, lane); __syncthreads(); }
#endif
            }
            else { A = (const bf16*)(ws + WS_QH); K = DM; Bt = (const bf16*)(ws + WS_WO); scale = 1.0f; }
            if (arg == 3) {
                if (dry) scale = 0.f;
                pg8::EpiResid E{res, p.out, scale};
                run_gemm(lds, A, Bt, DM, K, E);
            } else {
                const float* g1 = p.in[1] + (arg == 0 ? 1 : (arg == 4 ? 2 : (arg == 1 ? 3 : (arg == 2 ? 4 : 5)))) * DM;
                const float* g2 = p.in[8];
#pragma unroll 1
                for (int half = 0; half < 2; ++half) {
                    pg8::EpiResidNorm<GridBarFn, WS_SSP, WS_XN, WS_XN3> E{res, p.out, ws, g1, g2, (unsigned*)(ws + WS_BAR), scale, half * (MTOK / 2), arg == 1 ? 1 : 0, (unsigned)(size_t)bst};
                    pg8::Gemm g{A + (size_t)half * (MTOK / 2) * K, Bt, MTOK / 2, DM, K}; pg8::StaticOrder S; S.init(MTOK / 2, DM, (int)gridDim.x, (int)blockIdx.x);
                    pg8::gemm_phase<decltype(E), pg8::StaticOrder, false, true>((LAS unsigned char*)lds, g, S, E);
                    __syncthreads();
                }
            }
        } else if (type == T_AIN) {
            pg8::EpiAin<WS_QH, WS_LF, WS_VH, WS_GH> E{ws, p.in[5]};
#ifndef SK_G3
            run_gemm(lds, XN, (const bf16*)(ws + WS_WAIN), 4096, DM, E);
#endif
        } else if (type == T_HA) {
#ifndef SK_HA
            hgrn_pass_a(p, lds);
#endif
        } else if (type == T_HB) {
#ifndef SK_HB
            hgrn_pass_b(p, dry);
#endif
        } else if (type == T_HC) {
#ifndef SK_HC
            hgrn_pass_c(p, lds, dry);
#endif
        } else if (type == T_QKV) {
#pragma unroll 1
            for (int j = 0; j < 2; ++j) {
                const bf16* A = j == 0 ? XN : XN3;
                const bf16* Bt = j == 0 ? (const bf16*)(ws + WS_WQ) + (size_t)arg * 1024 * DM : (const bf16*)(ws + WS_WKV) + (size_t)arg * 2048 * DM;
                pg8::EpiBf16 E{(bf16*)(ws + (j == 0 ? WS_QG : WS_KG)), DM, arg * 2};
                run_gemm(lds, A, Bt, j == 0 ? DM : 2 * DM, DM, E);
            }
        } else {
#ifndef SK_ATT
            attn_group(p, lds, arg);
#endif
        }
        if (ph + 1 < ph_hi) {
            if (ph == p0.ph_lo) grid.sync();
            else { XcdBarrier xb; xb.bar = (unsigned*)(ws + WS_BAR); xb.x = xb_xcc_id(); xb.st = bst; xcd_barrier(xb); }
        }
    }
}

extern "C" void kernel_launch(void* const* d_in, const int* in_sizes, int n_in, void* d_out, int out_size, void* d_ws, size_t ws_size, hipStream_t stream) {
    static int grid = 0;
    if (grid == 0) {
        if (n_in != 15 || out_size != MTOK * DM || ws_size < WS_END) { fprintf(stderr, "kernel_launch: unexpected shapes (n_in %d out %d ws %zu)\n", n_in, out_size, ws_size); grid = -1; return; }
        int dev = 0, cus = 0, per_cu = 0;
        hipGetDevice(&dev); hipDeviceGetAttribute(&cus, hipDeviceAttributeMultiprocessorCount, dev);
        hipFuncSetAttribute((const void*)yoco_fwd, hipFuncAttributeMaxDynamicSharedMemorySize, LDS_BYTES);
        hipOccupancyMaxActiveBlocksPerMultiprocessor(&per_cu, (const void*)yoco_fwd, 512, LDS_BYTES);
        if (per_cu < 1) per_cu = 1;
        (void)hipGetLastError();
        grid = cus * per_cu;
    }
    if (grid < 0) return;
    if (hipMemsetAsync((char*)d_ws, 0, 262144, stream) != hipSuccess) { fprintf(stderr, "kernel_launch: memset failed\n"); return; }
    Params p{};
    for (int i = 0; i < 15; ++i) p.in[i] = (const float*)d_in[i];
    p.out = (float*)d_out; p.ws = (unsigned char*)d_ws;
#if defined(MK_MULTI)
    for (int ph = 0; ph < NPH; ++ph) { p.ph_lo = ph; p.ph_hi = ph + 1; hipLaunchKernelGGL(yoco_fwd, dim3(grid), dim3(512), LDS_BYTES, stream, p); }
#else
#ifdef PROBE_PH
    p.ph_lo = 0; p.ph_hi = NPH + 1;
#else
    p.ph_lo = 0; p.ph_hi = NPH;
#endif
    void* args[] = {&p};
    hipError_t e = hipLaunchCooperativeKernel((const void*)yoco_fwd, dim3(grid), dim3(512), args, LDS_BYTES, stream);
    if (e != hipSuccess) fprintf(stderr, "cooperative launch failed: %s (grid %d)\n", hipGetErrorString(e), grid);
#endif
}
```
